# Optimizing an MI355X kernel written in HIP

```python
import jax, jax.numpy as jnp
from jax import lax
import numpy as np

D_MODEL = 1024
BATCH = 2
SEQ = 16384
DEPTH = 4

D_PLE = 256
D_FF = 4 * D_MODEL
HEAD_DIM = 64
D_A = 3 * D_MODEL // 8
D_B = 3 * D_MODEL // 8
D_C = D_MODEL - D_A - D_B
N_HEADS_A = D_A // HEAD_DIM
N_HEADS_B = D_B // HEAD_DIM
POOL_WINDOWS = (2, 4, 8, 16)
N_POOL_GROUPS = len(POOL_WINDOWS)
D_POOL_GROUP = D_C // N_POOL_GROUPS
CHUNK = 128
CONV_WIDTH = 3
D_IN = 2 * D_A + 3 * D_B + D_C
SPLITS = (D_A, 2 * D_A, 2 * D_A + D_B, 2 * D_A + 2 * D_B, 2 * D_A + 3 * D_B)
RMS_EPS = 1e-6
LN_EPS = 1e-5

kernel_name = "hybrid_sgu_conv_pool_trunk"


def rms_norm(x, g):
    xf = x.astype(jnp.float32)
    y = xf * lax.rsqrt(jnp.mean(xf * xf, axis=-1, keepdims=True) + RMS_EPS)
    return (y * g.astype(jnp.float32)).astype(x.dtype)


def spatial_gating(u, v, w_s, b_s, ln_g, ln_b):
    bsz, t, _ = u.shape
    n = t // CHUNK
    u = jax.nn.gelu(u, approximate=False)
    v = jax.nn.gelu(v, approximate=False)
    vf = v.reshape(bsz, n, CHUNK, N_HEADS_A, HEAD_DIM).astype(jnp.float32)
    mu = jnp.mean(vf, axis=-1, keepdims=True)
    var = jnp.mean(jnp.square(vf - mu), axis=-1, keepdims=True)
    vn = ((vf - mu) * lax.rsqrt(var + LN_EPS)
          * ln_g.reshape(N_HEADS_A, HEAD_DIM).astype(jnp.float32)
          + ln_b.reshape(N_HEADS_A, HEAD_DIM).astype(jnp.float32)).astype(u.dtype)
    mask = jnp.tril(jnp.ones((CHUNK, CHUNK), dtype=bool))
    w = jnp.where(mask[None], w_s, jnp.zeros((), w_s.dtype)).astype(u.dtype)
    mixed = jnp.einsum('hts,bnshd->bnthd', w, vn) + b_s.T.astype(u.dtype)[:, :, None]
    return u * mixed.reshape(bsz, t, D_A)


def short_conv(z, gate_b, gate_c, conv_w):
    h = gate_c * z
    y = lax.conv_general_dilated(
        h, conv_w.astype(h.dtype)[:, None, :], window_strides=(1,),
        padding=[(CONV_WIDTH - 1, 0)],
        dimension_numbers=('NWC', 'WIO', 'NWC'), feature_group_count=D_B)
    return gate_b * y


def multiscale_pool(z, w_pool, pool_scale):
    bsz, t, _ = z.shape
    zf = z.astype(jnp.float32)
    cs = jnp.cumsum(zf, axis=1)
    pos_count = jnp.arange(1, t + 1, dtype=jnp.float32)
    outs = []
    for g, win in enumerate(POOL_WINDOWS):
        sl = slice(g * D_POOL_GROUP, (g + 1) * D_POOL_GROUP)
        c = cs[..., sl]
        lag = jnp.pad(c, ((0, 0), (win, 0), (0, 0)))[:, :t]
        mean = (c - lag) / jnp.minimum(pos_count, float(win))[None, :, None]
        outs.append(mean - zf[..., sl])
    pooled = jnp.stack(outs, axis=2).astype(z.dtype)
    y = jnp.einsum('btgc,gcd->btgd', pooled, w_pool)
    return y.reshape(bsz, t, D_C) * pool_scale


def setup_inputs(seed: int = 0) -> dict:
    key = jax.random.key(seed)
    ks = jax.random.split(key, 20)
    f32 = jnp.float32
    nrm = lambda k, shape, scale: jax.random.normal(k, shape, f32) * scale
    return {
        "x": nrm(ks[0], (BATCH, SEQ, D_MODEL), 1.0),
        "p": nrm(ks[1], (DEPTH, BATCH, SEQ, D_PLE), 1.0),
        "norm_mix_g": 1.0 + nrm(ks[2], (DEPTH, D_MODEL), 0.05),
        "w_in": nrm(ks[3], (DEPTH, D_MODEL, D_IN), D_MODEL ** -0.5),
        "sgu_w": nrm(ks[4], (DEPTH, N_HEADS_A, CHUNK, CHUNK), CHUNK ** -0.5),
        "sgu_b": 1.0 + nrm(ks[5], (DEPTH, N_HEADS_A, CHUNK), 0.1),
        "sgu_ln_g": 1.0 + nrm(ks[6], (DEPTH, D_A), 0.05),
        "sgu_ln_b": nrm(ks[7], (DEPTH, D_A), 0.02),
        "conv_w": nrm(ks[8], (DEPTH, CONV_WIDTH, D_B), CONV_WIDTH ** -0.5),
        "pool_w": nrm(ks[9], (DEPTH, N_POOL_GROUPS, D_POOL_GROUP, D_POOL_GROUP), D_POOL_GROUP ** -0.5),
        "pool_scale": 1.0 + nrm(ks[10], (DEPTH, D_C), 0.1),
        "w_out": nrm(ks[11], (DEPTH, D_MODEL, D_MODEL), D_MODEL ** -0.5),
        "norm_ff_g": 1.0 + nrm(ks[12], (DEPTH, D_MODEL), 0.05),
        "w_ff1": nrm(ks[13], (DEPTH, D_MODEL, D_FF), D_MODEL ** -0.5),
        "w_ff2": nrm(ks[14], (DEPTH, D_FF, D_MODEL), D_FF ** -0.5),
        "norm_ple_g": 1.0 + nrm(ks[15], (DEPTH, D_MODEL), 0.05),
        "w_ple_gate": nrm(ks[16], (DEPTH, D_MODEL, D_MODEL), D_MODEL ** -0.5),
        "w_ple_proj": nrm(ks[17], (DEPTH, D_PLE, D_MODEL), D_PLE ** -0.5),
        "final_g": 1.0 + nrm(ks[18], (D_MODEL,), 0.05),
    }


def reference(x, p, norm_mix_g, w_in, sgu_w, sgu_b, sgu_ln_g, sgu_ln_b, conv_w,
              pool_w, pool_scale, w_out, norm_ff_g, w_ff1, w_ff2, norm_ple_g,
              w_ple_gate, w_ple_proj, final_g):
    for i in range(DEPTH):
        h = rms_norm(x, norm_mix_g[i])
        proj = h @ w_in[i]
        u_a, v_a, z_b, g_b, g_c, z_c = jnp.split(proj, SPLITS, axis=-1)
        y_a = spatial_gating(u_a, v_a, sgu_w[i], sgu_b[i], sgu_ln_g[i], sgu_ln_b[i])
        y_b = short_conv(z_b, g_b, g_c, conv_w[i])
        y_c = multiscale_pool(z_c, pool_w[i], pool_scale[i])
        x = x + jnp.concatenate([y_a, y_b, y_c], axis=-1) @ w_out[i]
        h = rms_norm(x, norm_ff_g[i])
        x = x + jnp.square(jax.nn.relu(h @ w_ff1[i])) @ w_ff2[i]
        gate = jax.nn.sigmoid(rms_norm(x, norm_ple_g[i]) @ w_ple_gate[i])
        x = x + (p[i] @ w_ple_proj[i]) * gate
    return rms_norm(x, final_g)
```

```cpp
#include <hip/hip_runtime.h>
#include <hip/hip_cooperative_groups.h>
#include <cstdio>
#include <cstdint>
namespace cg = cooperative_groups;

#define LAS __attribute__((address_space(3)))
typedef unsigned short bf16_t;
typedef short bf16x8 __attribute__((ext_vector_type(8)));
typedef float f32x4 __attribute__((ext_vector_type(4)));
typedef float f32x2 __attribute__((ext_vector_type(2)));
typedef unsigned u32x4 __attribute__((ext_vector_type(4)));
typedef unsigned u32x2 __attribute__((ext_vector_type(2)));

constexpr int M = 32768, SEQ = 16384, D = 1024, DIN = 2176, DINP = 2304, FF = 4096, DPLE = 256, DEPTH = 4;
constexpr int OFF_UA = 0, OFF_VA = 384, OFF_ZB = 768, OFF_GB = 1152, OFF_GC = 1536, OFF_ZC = 1920;
constexpr float RMS_EPS = 1e-6f, LN_EPS = 1e-5f;

constexpr size_t MiB = 1u << 20, KiB = 1u << 10;
constexpr size_t WS_W = 1 * MiB, LW = 26 * MiB;
constexpr size_t LW_IN = 0, LW_OUT = 4608 * KiB, LW_FF1 = LW_OUT + 2 * MiB, LW_FF2 = LW_FF1 + 8 * MiB, LW_G = LW_FF2 + 8 * MiB, LW_P = LW_G + 2 * MiB,
                 LW_SGU = LW_P + 512 * KiB, LW_POOL = LW_SGU + 192 * KiB;
static_assert(LW_POOL + 32 * KiB <= LW, "layer weights");
constexpr size_t WS_XB = WS_W + 4 * LW;
constexpr size_t WS_PB = WS_XB + 64 * MiB;
constexpr size_t WS_SSQ = WS_PB + 64 * MiB;
constexpr size_t WS_R1 = WS_SSQ + 2 * MiB;
constexpr size_t XS = 32 * MiB, SL_PROJ = 0, SL_YCAT = 18 * MiB, SL_HID = 0, SL_GATE = 0;
__device__ __forceinline__ size_t slice_off(int row) { return WS_R1 + (size_t)(row >> 12) * XS; }
constexpr size_t WS_END = WS_R1 + 256 * MiB;

constexpr size_t WS_SM_SGUB = 128 * KiB, WS_SM_LNG = 144 * KiB, WS_SM_LNB = 160 * KiB, WS_SM_CONV = 176 * KiB, WS_SM_FG = 208 * KiB;
constexpr int LDS_BYTES = 147456;

typedef __bf16 bf16x2_t __attribute__((ext_vector_type(2)));
__device__ __forceinline__ unsigned cvt_pk_bf16(float lo, float hi) { const f32x2 v = {lo, hi}; return __builtin_bit_cast(unsigned, __builtin_convertvector(v, bf16x2_t)); }
__device__ __forceinline__ float bf_lo(unsigned w) { return __uint_as_float(w << 16); }
__device__ __forceinline__ float bf_hi(unsigned w) { return __uint_as_float(w & 0xffff0000u); }
__device__ __forceinline__ f32x2 gelu_pk(f32x2 v) {
    const f32x2 av = __builtin_elementwise_abs(v), d = av * 0.2316418882f + 1.0f;
    f32x2 t; t.x = __builtin_amdgcn_rcpf(d.x); t.y = __builtin_amdgcn_rcpf(d.y);
    f32x2 q = t * 0.5307027145f + (-0.7265760135f); q = q * t + 0.7107068705f; q = q * t + (-0.142248368f); q = q * t + 0.127414796f; q = q * t;
    const f32x2 s = (v * v) * (-0.72134752044f);
    f32x2 e; e.x = __builtin_amdgcn_exp2f(s.x); e.y = __builtin_amdgcn_exp2f(s.y);
    const f32x2 m = v * (q * e), r = v - m;
    f32x2 o; o.x = v.x < 0.f ? m.x : r.x; o.y = v.y < 0.f ? m.y : r.y; return o;
}

namespace pg8 {
constexpr int BM = 256, BK = 64, HALF = 128, HTB = HALF * BK * 2, STAGE_BYTES = 8 * HTB, NXCD = 8, WGM = 8;
__host__ __device__ __forceinline__ int lds_byte(int r, int c) { const int st = (r >> 4) * 2 + (c >> 5), rr = r & 15, cc = c & 31, ob = rr * 64 + cc * 2; return st * 1024 + (ob ^ (((ob >> 9) & 1) << 5)); }
__host__ __device__ __forceinline__ void stage_rc(int b, int& R, int& C) { const int st = b / 1024, sb = b % 1024, swz = sb ^ (((sb >> 9) & 1) << 5); R = (st >> 1) * 16 + swz / 64; C = (st & 1) * 32 + (swz % 64) / 2; }
__host__ __device__ __forceinline__ int perm32(int rho) { const int n = rho >> 4, i = rho & 15; return 8 * (i >> 2) + 4 * n + (i & 3); }

struct Unit { int pm, pn; };
struct Gemm { const bf16_t* A; const bf16_t* Bt; int M, N, K; size_t axs; };

struct StaticOrder {
    int nM, nN, nwg, G, c;
    __host__ __device__ void init(int M_, int N_, int G_, int c_) { nM = M_ / BM; nN = N_ / BM; nwg = nM * nN; G = G_; c = c_; }
    __host__ __device__ bool next(int i, Unit& u) const {
        const long L = (long)i * G + c; if (L >= nwg) return false;
        int wgid = (int)L; { const int q = nwg / NXCD, r = nwg % NXCD, xcd = wgid % NXCD, off = wgid / NXCD; wgid = (xcd < r ? xcd * (q + 1) : r * (q + 1) + (xcd - r) * q) + off; }
        const int nig = WGM * nN, gid = wgid / nig, fm = gid * WGM, gsz = (nM - fm) < WGM ? (nM - fm) : WGM;
        u.pm = fm + ((wgid % nig) % gsz); u.pn = (wgid % nig) / gsz; return true;
    }
    __device__ __forceinline__ void a_ready(const Unit&) const {}
    __device__ __forceinline__ void done(const Unit&) const {}
};

constexpr int RSL_OFF = 131072 + 1024;
template <class Sched, bool SYNC = true> __device__ __forceinline__ void fill_rs(LAS unsigned char* lds, const Sched& S, const unsigned char* ws) {
    int tid_ = threadIdx.x; asm volatile("" : "+v"(tid_));
    const float* ssqp = (const float*)(ws + WS_SSQ); LAS float* rsl = (LAS float*)(lds + RSL_OFF);
    const int half = tid_ >> 8, r = tid_ & 255;
    Unit u;
    for (int i = half; S.next(i, u); i += 2) {
        const f32x4* sp = (const f32x4*)(ssqp + (unsigned)(u.pm * BM + r) * 16);
        const f32x4 s4 = (sp[0] + sp[1]) + (sp[2] + sp[3]);
        rsl[i * 256 + r] = __builtin_amdgcn_rsqf(((s4[0] + s4[1]) + (s4[2] + s4[3])) * (1.0f / D) + RMS_EPS);
    }
    if (SYNC) __syncthreads();
}
struct NoPre { template <class Sched> __device__ __forceinline__ void operator()(LAS unsigned char*, const Sched&) const {} };
struct RsPre { const unsigned char* ws; template <class Sched> __device__ __forceinline__ void operator()(LAS unsigned char* lds, const Sched& S) const { fill_rs<Sched, false>(lds, S, ws); } };
template <int N> __device__ __forceinline__ void wait_vm() { asm volatile("s_waitcnt vmcnt(%0)" :: "n"(N) : "memory"); }
template <int RELAXED> __device__ __forceinline__ void wait_vm8_or(int relaxed) {
    asm volatile("s_cmp_lg_u32 %0, 0\n\ts_cbranch_scc1 .Lwr%=\n\ts_waitcnt vmcnt(8)\n\ts_branch .Lwe%=\n.Lwr%=:\n\ts_waitcnt vmcnt(%1)\n.Lwe%=:" :: "s"(relaxed), "n"(RELAXED) : "scc", "memory"); }
template <int ACT> struct EpiProj {
    static constexpr bool PERM = true, AFTER_DRAIN = false; static constexpr int NST = ACT == 0 ? 8 : 16;
    bf16_t* O; int ldc;
    __device__ __forceinline__ void operator()(const f32x4 (&acc)[2][2][4][2], const Unit& u, int ui, LAS unsigned char* lds, int wr, int wc, int fr, int fq) const {
        const LAS float* rsl = (const LAS float*)(lds + RSL_OFF) + ui * 256 + wr * 64 + fr;
        const int row0 = (u.pm & 15) * BM + wr * 64 + fr, col0 = u.pn * BM + wc * 32 + 8 * fq; bf16_t* Os = O + (size_t)(u.pm >> 4) * (XS / 2);
#pragma unroll
        for (int ai = 0; ai < 2; ++ai)
#pragma unroll
            for (int m = 0; m < 4; ++m) {
                const int row = row0 + ai * HALF + m * 16; const float rs = rsl[ai * HALF + m * 16];
                bf16_t* rowp = Os + (size_t)row * ldc + col0;
#pragma unroll
                for (int bj = 0; bj < 2; ++bj) {
                    if (ACT == 0 && bj == 1 && u.pn * BM + HALF >= DIN) continue;
                    f32x4 v0 = acc[ai][bj][m][0] * rs, v1 = acc[ai][bj][m][1] * rs;
                    if (ACT == 1) {
#pragma unroll
                        for (int j = 0; j < 4; ++j) { const float a = fmaxf(v0[j], 0.f), b = fmaxf(v1[j], 0.f); v0[j] = a * a; v1[j] = b * b; }
                    }
                    u32x4 w; w.x = cvt_pk_bf16(v0[0], v0[1]); w.y = cvt_pk_bf16(v0[2], v0[3]); w.z = cvt_pk_bf16(v1[0], v1[1]); w.w = cvt_pk_bf16(v1[2], v1[3]);
                    *(u32x4*)(rowp + bj * HALF) = w;
                }
            }
    }
};
struct EpiGate {
    static constexpr bool PERM = true, AFTER_DRAIN = false; static constexpr int NST = 16;
    unsigned char* ws;
    __device__ __forceinline__ void operator()(const f32x4 (&acc)[2][2][4][2], const Unit& u, int ui, LAS unsigned char* lds, int wr, int wc, int fr, int fq) const {
        const LAS float* rsl = (const LAS float*)(lds + RSL_OFF) + ui * 256 + wr * 64 + fr; bf16_t* gate = (bf16_t*)(ws + WS_R1 + (size_t)(u.pm >> 4) * XS + SL_GATE);
        const int row0 = (u.pm & 15) * BM + wr * 64 + fr, col0 = u.pn * BM + wc * 32 + 8 * fq;
#pragma unroll
        for (int ai = 0; ai < 2; ++ai)
#pragma unroll
            for (int m = 0; m < 4; ++m) {
                const unsigned off = (unsigned)(row0 + ai * HALF + m * 16) * D + col0; const float rs = rsl[ai * HALF + m * 16];
#pragma unroll
                for (int bj = 0; bj < 2; ++bj) {
                    f32x4 v0 = acc[ai][bj][m][0] * rs, v1 = acc[ai][bj][m][1] * rs;
#pragma unroll
                    for (int j = 0; j < 4; ++j) { v0[j] = __builtin_amdgcn_rcpf(1.0f + __builtin_amdgcn_exp2f(-1.44269504089f * v0[j])); v1[j] = __builtin_amdgcn_rcpf(1.0f + __builtin_amdgcn_exp2f(-1.44269504089f * v1[j])); }
                    u32x4 w; w.x = cvt_pk_bf16(v0[0], v0[1]); w.y = cvt_pk_bf16(v0[2], v0[3]); w.z = cvt_pk_bf16(v1[0], v1[1]); w.w = cvt_pk_bf16(v1[2], v1[3]);
                    *(u32x4*)(gate + off + bj * HALF) = w;
                }
            }
    }
};
template <bool GATED> struct EpiRes {
    static constexpr bool PERM = true, AFTER_DRAIN = false; static constexpr int NST = 24;
    unsigned char* ws;
    __device__ __forceinline__ void operator()(const f32x4 (&acc)[2][2][4][2], const Unit& u, int ui, LAS unsigned char* lds, int wr, int wc, int fr, int fq) const {
        bf16_t* xb = (bf16_t*)(ws + WS_XB); float* ssqp = (float*)(ws + WS_SSQ); const bf16_t* gate = (const bf16_t*)(ws + WS_R1 + (size_t)(u.pm >> 4) * XS + SL_GATE) - (size_t)(u.pm >> 4) * 4096 * D;
        const int row0 = u.pm * BM + wr * 64 + fr, col0 = u.pn * BM + wc * 32 + 8 * fq;
#pragma unroll
        for (int ai = 0; ai < 2; ++ai) {
            u32x4 b[4][2], g[4][2];
#pragma unroll
            for (int m = 0; m < 4; ++m) { const unsigned off = (unsigned)(row0 + ai * HALF + m * 16) * D + col0;
#pragma unroll
                for (int bj = 0; bj < 2; ++bj) { const unsigned c = off + bj * HALF; b[m][bj] = *(const u32x4*)(xb + c); if (GATED) g[m][bj] = *(const u32x4*)(gate + c); } }
#pragma unroll
            for (int m = 0; m < 4; ++m) { const int row = row0 + ai * HALF + m * 16; const unsigned off = (unsigned)row * D + col0; float q = 0.f;
#pragma unroll
                for (int bj = 0; bj < 2; ++bj) { const unsigned c = off + bj * HALF; f32x4 a0 = acc[ai][bj][m][0], a1 = acc[ai][bj][m][1];
                    if (GATED) { const u32x4 gg = g[m][bj]; a0[0] *= bf_lo(gg.x); a0[1] *= bf_hi(gg.x); a0[2] *= bf_lo(gg.y); a0[3] *= bf_hi(gg.y); a1[0] *= bf_lo(gg.z); a1[1] *= bf_hi(gg.z); a1[2] *= bf_lo(gg.w); a1[3] *= bf_hi(gg.w); }
                    const u32x4 bb = b[m][bj];
                    const f32x4 o0 = (f32x4){bf_lo(bb.x), bf_hi(bb.x), bf_lo(bb.y), bf_hi(bb.y)} + a0, o1 = (f32x4){bf_lo(bb.z), bf_hi(bb.z), bf_lo(bb.w), bf_hi(bb.w)} + a1;
                    u32x4 w; w.x = cvt_pk_bf16(o0[0], o0[1]); w.y = cvt_pk_bf16(o0[2], o0[3]); w.z = cvt_pk_bf16(o1[0], o1[1]); w.w = cvt_pk_bf16(o1[2], o1[3]); *(u32x4*)(xb + c) = w;
                    q += ((o0[0] * o0[0] + o0[1] * o0[1]) + (o0[2] * o0[2] + o0[3] * o0[3])) + ((o1[0] * o1[0] + o1[1] * o1[1]) + (o1[2] * o1[2] + o1[3] * o1[3])); }
                q += __shfl_xor(q, 16); q += __shfl_xor(q, 32);
                if (fq == 0) ssqp[(unsigned)row * 16 + u.pn * 4 + wc] = q; }
            asm volatile("" ::: "memory");
        }
    }
};

template <class Epi, class Sched, bool ALIGN_EPI = false, bool SP2 = false, class Pre = NoPre>
__device__ __forceinline__ void gemm_phase(LAS unsigned char* lds, const Gemm g, const Sched& S, const Epi& E, const Pre& pre = Pre()) {
    int tid_ = threadIdx.x; asm volatile("" : "+v"(tid_));
    const int tid = tid_, wid = __builtin_amdgcn_readfirstlane(tid >> 6), lane = tid & 63, wr = wid >> 2, wc = wid & 3, fr = lane & 15, fq = lane >> 4;
    int K_ = g.K; asm volatile("" : "+s"(K_));
    const int K = K_, nt = K / BK;
    unsigned voffA[2], voffB[2];
#pragma unroll
    for (int i = 0; i < 2; ++i) { int R, C; stage_rc(tid * 16 + i * 8192, R, C); const int Rb = Epi::PERM ? ((R & ~31) + perm32(R & 31)) : R;
        voffA[i] = (unsigned)(R * K + C) * 2u; voffB[i] = (unsigned)(Rb * K + C) * 2u; }
    const size_t kstep = (size_t)(BK * 2);
    const size_t hstep = (size_t)HALF * K * 2;
    const size_t tstep = 2 * hstep;
    const unsigned ldsw = (unsigned)wid * 1024u;
    const int aoff = lds_byte(wr * 64 + fr, fq * 8), boff = lds_byte(wc * 32 + fr, fq * 8);
#define PG8_SA(b, h) (((b) * 2 + (h)) * HTB)
#define PG8_SB(b, h) ((4 + (b) * 2 + (h)) * HTB)
#define PG8_STAGE(bufoff, gbase, voff) do { _Pragma("unroll") for (int _i = 0; _i < 2; ++_i) \
        __builtin_amdgcn_global_load_lds((const unsigned*)((const char*)(gbase) + (voff)[_i]), (LAS unsigned*)(lds + (bufoff) + ldsw + _i * 8192), 16, 0, 0); } while (0)
#define PG8_LDA(dst, b, h) do { _Pragma("unroll") for (int m = 0; m < 4; ++m) _Pragma("unroll") for (int k = 0; k < 2; ++k) dst[m][k] = *(const LAS bf16x8*)(lds + PG8_SA(b, h) + aoff + m * 2048 + k * 1024); } while (0)
#define PG8_LDB(dst, b, h) do { _Pragma("unroll") for (int n = 0; n < 2; ++n) _Pragma("unroll") for (int k = 0; k < 2; ++k) dst[n][k] = *(const LAS bf16x8*)(lds + PG8_SB(b, h) + boff + n * 2048 + k * 1024); } while (0)
#define PG8_MMA(ai, bj, At, Bt) do { __builtin_amdgcn_s_setprio(1); _Pragma("unroll") for (int m = 0; m < 4; ++m) _Pragma("unroll") for (int n = 0; n < 2; ++n) _Pragma("unroll") for (int k = 0; k < 2; ++k) \
        acc[ai][bj][m][n] = __builtin_amdgcn_mfma_f32_16x16x32_bf16(Bt[n][k], At[m][k], acc[ai][bj][m][n], 0, 0, 0); __builtin_amdgcn_s_setprio(0); } while (0)
#define PG8_WAIT_V(n) asm volatile("s_waitcnt vmcnt(" #n ")" ::: "memory")
#define PG8_WAIT_L(n) asm volatile("s_waitcnt lgkmcnt(" #n ")" ::: "memory")
#define PG8_BAR __builtin_amdgcn_s_barrier()
#define PG8_SCHED __builtin_amdgcn_sched_barrier(0)
    Unit cur, nxt; int ui = 0;
    if (!S.next(0, cur)) return;
    f32x4 acc[2][2][4][2];
#pragma unroll
    for (int a = 0; a < 2; ++a)
#pragma unroll
        for (int b = 0; b < 2; ++b)
#pragma unroll
            for (int m = 0; m < 4; ++m)
#pragma unroll
                for (int n = 0; n < 2; ++n) acc[a][b][m][n] = (f32x4){0.f, 0.f, 0.f, 0.f};
    bf16x8 At[4][2], B0[2][2], B1[2][2];
    const char* cA = (const char*)g.A + (size_t)(cur.pm >> 4) * g.axs + (size_t)(cur.pm & 15) * tstep; const char* cB = (const char*)g.Bt + (size_t)cur.pn * tstep;
    S.a_ready(cur);
    if constexpr (SP2) {
        PG8_STAGE(PG8_SB(0, 0), cB, voffB); PG8_STAGE(PG8_SB(0, 1), cB + hstep, voffB); PG8_STAGE(PG8_SA(0, 0), cA, voffA); PG8_STAGE(PG8_SA(0, 1), cA + hstep, voffA);
        if (wr == 1) PG8_BAR;
        PG8_WAIT_V(2); PG8_BAR;
        PG8_STAGE(PG8_SB(1, 0), cB + kstep, voffB); PG8_STAGE(PG8_SA(1, 0), cA + kstep, voffA); PG8_STAGE(PG8_SB(1, 1), cB + hstep + kstep, voffB);
        pre(lds, S);
        PG8_WAIT_V(6); PG8_BAR;
    } else {
        PG8_STAGE(PG8_SB(0, 0), cB, voffB); PG8_STAGE(PG8_SA(0, 0), cA, voffA); PG8_STAGE(PG8_SB(0, 1), cB + hstep, voffB); PG8_STAGE(PG8_SA(0, 1), cA + hstep, voffA);
        if (wr == 1) PG8_BAR;
        PG8_WAIT_V(4); PG8_BAR;
        PG8_STAGE(PG8_SB(1, 0), cB + kstep, voffB); PG8_STAGE(PG8_SA(1, 0), cA + kstep, voffA); PG8_STAGE(PG8_SB(1, 1), cB + hstep + kstep, voffB);
        PG8_WAIT_V(6); PG8_BAR;
    }
    for (;;) {
        const bool has_next = S.next(ui + 1, nxt);
        const char* nA = has_next ? (const char*)g.A + (size_t)(nxt.pm >> 4) * g.axs + (size_t)(nxt.pm & 15) * tstep : cA; const char* nB = has_next ? (const char*)g.Bt + (size_t)nxt.pn * tstep : cB;
        for (int t = 0; t < nt; t += 2) {
            const bool last = (t == nt - 2);
            const char* a1 = cA + (size_t)(t + 1) * kstep;
            const char* a2 = last ? nA : cA + (size_t)(t + 2) * kstep; const char* b2 = last ? nB : cB + (size_t)(t + 2) * kstep;
            const char* a3 = a2 + kstep; const char* b3 = b2 + kstep;
            if (last && has_next) S.a_ready(nxt);
            if constexpr (SP2) {
            const int fresh = __builtin_amdgcn_readfirstlane((ui > 0 && t == 0) ? 1 : 0);
            PG8_LDB(B0, 0, 0); PG8_LDB(B1, 0, 1); PG8_SCHED; PG8_LDA(At, 0, 0); PG8_STAGE(PG8_SA(1, 1), a1 + hstep, voffA);
            wait_vm8_or<8 + Epi::NST>(fresh);
            PG8_WAIT_L(0); PG8_BAR; PG8_MMA(0, 0, At, B0); PG8_MMA(0, 1, At, B1); PG8_BAR; PG8_SCHED;
            PG8_LDA(At, 0, 1); PG8_STAGE(PG8_SB(0, 0), b2, voffB); PG8_STAGE(PG8_SB(0, 1), b2 + hstep, voffB); PG8_STAGE(PG8_SA(0, 0), a2, voffA);
            wait_vm8_or<8 + Epi::NST>(fresh);
            PG8_WAIT_L(0); PG8_BAR; PG8_MMA(1, 0, At, B0); PG8_MMA(1, 1, At, B1); PG8_BAR; PG8_SCHED;
            PG8_LDB(B0, 1, 0); PG8_LDB(B1, 1, 1); PG8_SCHED; PG8_LDA(At, 1, 0); PG8_STAGE(PG8_SA(0, 1), a2 + hstep, voffA);
            PG8_WAIT_V(8); PG8_WAIT_L(0); PG8_BAR; PG8_MMA(0, 0, At, B0); PG8_MMA(0, 1, At, B1); PG8_BAR; PG8_SCHED;
            PG8_LDA(At, 1, 1); PG8_STAGE(PG8_SB(1, 0), b3, voffB); PG8_STAGE(PG8_SB(1, 1), b3 + hstep, voffB); PG8_STAGE(PG8_SA(1, 0), a3, voffA);
            PG8_WAIT_V(8); PG8_WAIT_L(0); PG8_BAR; PG8_MMA(1, 0, At, B0); PG8_MMA(1, 1, At, B1); PG8_BAR; PG8_SCHED;
            } else {
            PG8_LDB(B0, 0, 0); PG8_SCHED; PG8_LDA(At, 0, 0); PG8_STAGE(PG8_SA(1, 1), a1 + hstep, voffA);
            PG8_WAIT_L(8); PG8_BAR; PG8_WAIT_L(0); PG8_MMA(0, 0, At, B0); PG8_BAR; PG8_SCHED;
            PG8_LDB(B1, 0, 1); PG8_STAGE(PG8_SB(0, 0), b2, voffB);
            PG8_BAR; PG8_WAIT_L(0); PG8_MMA(0, 1, At, B1); PG8_BAR;
            PG8_LDA(At, 0, 1); PG8_STAGE(PG8_SA(0, 0), a2, voffA);
            PG8_BAR; PG8_WAIT_L(0); PG8_MMA(1, 0, At, B0); PG8_BAR; PG8_SCHED;
            PG8_STAGE(PG8_SB(0, 1), b2 + hstep, voffB);
            PG8_WAIT_V(6); PG8_BAR; PG8_MMA(1, 1, At, B1); PG8_BAR;
            PG8_LDB(B0, 1, 0); PG8_SCHED; PG8_LDA(At, 1, 0); PG8_STAGE(PG8_SA(0, 1), a2 + hstep, voffA);
            PG8_WAIT_L(8); PG8_BAR; PG8_WAIT_L(0); PG8_MMA(0, 0, At, B0); PG8_BAR; PG8_SCHED;
            PG8_LDB(B1, 1, 1); PG8_STAGE(PG8_SB(1, 0), b3, voffB);
            PG8_BAR; PG8_WAIT_L(0); PG8_MMA(0, 1, At, B1); PG8_BAR;
            PG8_LDA(At, 1, 1); PG8_STAGE(PG8_SA(1, 0), a3, voffA);
            PG8_BAR; PG8_WAIT_L(0); PG8_MMA(1, 0, At, B0); PG8_BAR; PG8_SCHED;
            PG8_STAGE(PG8_SB(1, 1), b3 + hstep, voffB);
            PG8_WAIT_V(6); PG8_BAR; PG8_MMA(1, 1, At, B1); PG8_BAR;
            }
        }
        if constexpr (ALIGN_EPI) { if (wr == 0) PG8_BAR; }
        E(acc, cur, ui, lds, wr, wc, fr, fq); S.done(cur);
        if (!has_next) break;
#pragma unroll
        for (int a = 0; a < 2; ++a)
#pragma unroll
            for (int b = 0; b < 2; ++b)
#pragma unroll
                for (int m = 0; m < 4; ++m)
#pragma unroll
                    for (int n = 0; n < 2; ++n) acc[a][b][m][n] = (f32x4){0.f, 0.f, 0.f, 0.f};
        cur = nxt; cA = nA; cB = nB; ++ui;
        if constexpr (ALIGN_EPI) { if (wr == 1) PG8_BAR; }
    }
    PG8_WAIT_V(0);
    if constexpr (!ALIGN_EPI) { if (wr == 0) PG8_BAR; }
    PG8_BAR;
#undef PG8_SA
#undef PG8_SB
#undef PG8_STAGE
#undef PG8_LDA
#undef PG8_LDB
#undef PG8_MMA
#undef PG8_WAIT_V
#undef PG8_WAIT_L
#undef PG8_BAR
#undef PG8_SCHED
}
}

__device__ __forceinline__ void unpack8(const u32x4 r, float (&f)[8]) {
    f[0] = bf_lo(r.x); f[1] = bf_hi(r.x); f[2] = bf_lo(r.y); f[3] = bf_hi(r.y); f[4] = bf_lo(r.z); f[5] = bf_hi(r.z); f[6] = bf_lo(r.w); f[7] = bf_hi(r.w);
}
__device__ __forceinline__ u32x4 pack8(const float (&f)[8]) {
    u32x4 w; w.x = cvt_pk_bf16(f[0], f[1]); w.y = cvt_pk_bf16(f[2], f[3]); w.z = cvt_pk_bf16(f[4], f[5]); w.w = cvt_pk_bf16(f[6], f[7]); return w;
}
__device__ __forceinline__ void gelu8(float (&f)[8]) {
#pragma unroll
    for (int j = 0; j < 8; j += 2) { const f32x2 r = gelu_pk((f32x2){f[j], f[j + 1]}); f[j] = r.x; f[j + 1] = r.y; }
}

constexpr int VNT_STRIDE = 272, VNT_BYTES = 64 * VNT_STRIDE;
__device__ __forceinline__ const bf16_t* prow(const unsigned char* ws, int row) { return (const bf16_t*)(ws + slice_off(row) + SL_PROJ) + (size_t)(row & 4095) * DINP; }
template <int GRP>
__device__ __forceinline__ void pool_group(const unsigned char* __restrict__ ws, bf16_t* __restrict__ Yrow, const bf16_t* __restrict__ wpT, int G, int pos, int fr, int fq) {
    constexpr int win = 2 << GRP;
    f32x4 acc[4];
#pragma unroll
    for (int n = 0; n < 4; ++n) acc[n] = (f32x4){0.f, 0.f, 0.f, 0.f};
    const int cnt = (pos + 1) < win ? (pos + 1) : win;
    const float inv = 1.0f / (float)cnt;
#pragma unroll
    for (int ks = 0; ks < 2; ++ks) {
        const int c = GRP * 64 + ks * 32 + 8 * fq;
        constexpr int NB = win < 8 ? win : 8;
        bf16x8 bfr[4];
#pragma unroll
        for (int n = 0; n < 4; ++n) bfr[n] = *(const bf16x8*)(wpT + GRP * 4096 + (32 * (n >> 1) + 8 * (fr >> 2) + 4 * (n & 1) + (fr & 3)) * 64 + ks * 32 + 8 * fq);
        float s[8], z0[8];
#pragma unroll
        for (int j = 0; j < 8; ++j) { s[j] = 0.f; z0[j] = 0.f; }
#pragma unroll
        for (int j0 = 0; j0 < win; j0 += NB) {
            u32x4 r[NB];
#pragma unroll
            for (int jj = 0; jj < NB; ++jj) r[jj] = *(const u32x4*)(prow(ws, G - ((j0 + jj) < cnt ? (j0 + jj) : 0)) + OFF_ZC + c);
#pragma unroll
            for (int jj = 0; jj < NB; ++jj) { float v[8]; unpack8(r[jj], v); const float mk = (j0 + jj) < cnt ? 1.f : 0.f;
#pragma unroll
                for (int j = 0; j < 8; ++j) { s[j] += mk * v[j]; if (j0 + jj == 0) z0[j] = v[j]; } }
            if (j0 + NB < win) asm volatile("" ::: "memory");
        }
        float pl[8];
#pragma unroll
        for (int j = 0; j < 8; ++j) pl[j] = s[j] * inv - z0[j];
        const bf16x8 af = __builtin_bit_cast(bf16x8, pack8(pl));
#pragma unroll
        for (int n = 0; n < 4; ++n) acc[n] = __builtin_amdgcn_mfma_f32_16x16x32_bf16(bfr[n], af, acc[n], 0, 0, 0);
    }
    bf16_t* yp = Yrow + 768 + GRP * 64 + 8 * fq;
#pragma unroll
    for (int k = 0; k < 2; ++k) { u32x4 w; w.x = cvt_pk_bf16(acc[2 * k][0], acc[2 * k][1]); w.y = cvt_pk_bf16(acc[2 * k][2], acc[2 * k][3]); w.z = cvt_pk_bf16(acc[2 * k + 1][0], acc[2 * k + 1][1]); w.w = cvt_pk_bf16(acc[2 * k + 1][2], acc[2 * k + 1][3]); *(u32x4*)(yp + 32 * k) = w; }
}
__device__ __forceinline__ void mixer_chunk(LAS unsigned char* lds, int chunk, unsigned char* __restrict__ ws,
                                            const bf16_t* __restrict__ sguw, const float* __restrict__ sgub, const float* __restrict__ lng, const float* __restrict__ lnb,
                                            const float* __restrict__ convw, const bf16_t* __restrict__ wpT) {
    int tid_ = threadIdx.x; asm volatile("" : "+v"(tid_));
    const int tid = tid_, wid = __builtin_amdgcn_readfirstlane(tid >> 6), lane = tid & 63, fr = lane & 15, fq = lane >> 4;
    const int T0 = chunk * 128;
    const bf16_t* __restrict__ Pc = prow(ws, T0);
    bf16_t* __restrict__ Yc = (bf16_t*)(ws + slice_off(T0) + SL_YCAT) + (size_t)(T0 & 4095) * D;
    {
        const int pr = tid >> 3, q = tid & 7;
        const bf16_t* src = Pc + (size_t)(2 * pr) * DINP + OFF_VA + 8 * q;
#pragma unroll 1
        for (int hb = 0; hb < 6; hb += 3) {
        u32x4 r0[3], r1[3];
#pragma unroll
        for (int hh = 0; hh < 3; ++hh) { r0[hh] = *(const u32x4*)(src + (hb + hh) * 64); r1[hh] = *(const u32x4*)(src + DINP + (hb + hh) * 64); }
#pragma unroll
        for (int hh = 0; hh < 3; ++hh) { const int h = hb + hh;
            LAS unsigned char* buf = lds + h * VNT_BYTES;
            float a[8], b[8]; unpack8(r0[hh], a); unpack8(r1[hh], b); gelu8(a); gelu8(b);
            float s0 = 0.f, s1 = 0.f;
#pragma unroll
            for (int j = 0; j < 8; ++j) { s0 += a[j]; s1 += b[j]; }
            s0 += __shfl_xor(s0, 1); s1 += __shfl_xor(s1, 1); s0 += __shfl_xor(s0, 2); s1 += __shfl_xor(s1, 2); s0 += __shfl_xor(s0, 4); s1 += __shfl_xor(s1, 4);
            const float m0 = s0 * (1.f / 64.f), m1 = s1 * (1.f / 64.f);
            float q0 = 0.f, q1 = 0.f;
#pragma unroll
            for (int j = 0; j < 8; ++j) { a[j] -= m0; b[j] -= m1; q0 += a[j] * a[j]; q1 += b[j] * b[j]; }
            q0 += __shfl_xor(q0, 1); q1 += __shfl_xor(q1, 1); q0 += __shfl_xor(q0, 2); q1 += __shfl_xor(q1, 2); q0 += __shfl_xor(q0, 4); q1 += __shfl_xor(q1, 4);
            const float rs0 = __builtin_amdgcn_rsqf(q0 * (1.f / 64.f) + LN_EPS), rs1 = __builtin_amdgcn_rsqf(q1 * (1.f / 64.f) + LN_EPS);
            const f32x4 g0 = *(const f32x4*)(lng + h * 64 + 8 * q), g1 = *(const f32x4*)(lng + h * 64 + 8 * q + 4);
            const f32x4 c0 = *(const f32x4*)(lnb + h * 64 + 8 * q), c1 = *(const f32x4*)(lnb + h * 64 + 8 * q + 4);
#pragma unroll
            for (int j = 0; j < 8; ++j) {
                const float gg = j < 4 ? g0[j & 3] : g1[j & 3], cc = j < 4 ? c0[j & 3] : c1[j & 3];
                const unsigned w = cvt_pk_bf16(a[j] * rs0 * gg + cc, b[j] * rs1 * gg + cc);
                *(LAS unsigned*)(buf + (8 * q + j) * VNT_STRIDE + pr * 4) = w;
            }
        }
        }
    }
    if (tid < 384) {
        const int strip = tid / 48, grp = tid % 48, ch = grp * 8;
        float w0[8], w1[8], w2[8], hm2[8], hm1[8];
        { const f32x4 a0 = *(const f32x4*)(convw + ch), a1 = *(const f32x4*)(convw + ch + 4), b0 = *(const f32x4*)(convw + 384 + ch), b1 = *(const f32x4*)(convw + 384 + ch + 4),
                      c0 = *(const f32x4*)(convw + 768 + ch), c1 = *(const f32x4*)(convw + 768 + ch + 4);
#pragma unroll
          for (int j = 0; j < 4; ++j) { w0[j] = a0[j]; w0[j + 4] = a1[j]; w1[j] = b0[j]; w1[j + 4] = b1[j]; w2[j] = c0[j]; w2[j + 4] = c1[j]; } }
        const int tg0 = T0 + strip * 16, tl0 = strip * 16;
        {
            const bool first = (tg0 & (SEQ - 1)) == 0;
            const bf16_t* pz = prow(ws, first ? tg0 : tg0 - 2) + ch;
            float z[8], c[8]; const float mk = first ? 0.f : 1.f;
            unpack8(*(const u32x4*)(pz + OFF_ZB), z); unpack8(*(const u32x4*)(pz + OFF_GC), c);
#pragma unroll
            for (int j = 0; j < 8; ++j) hm2[j] = mk * z[j] * c[j];
            unpack8(*(const u32x4*)(pz + DINP + OFF_ZB), z); unpack8(*(const u32x4*)(pz + DINP + OFF_GC), c);
#pragma unroll
            for (int j = 0; j < 8; ++j) hm1[j] = mk * z[j] * c[j];
        }
#pragma unroll 1
        for (int i0 = 0; i0 < 16; i0 += 4) {
            u32x4 rz[4], rc[4], rg[4];
#pragma unroll
            for (int k = 0; k < 4; ++k) { const bf16_t* pz = Pc + (size_t)(tl0 + i0 + k) * DINP + ch; rz[k] = *(const u32x4*)(pz + OFF_ZB); rc[k] = *(const u32x4*)(pz + OFF_GC); rg[k] = *(const u32x4*)(pz + OFF_GB); }
#pragma unroll
            for (int k = 0; k < 4; ++k) {
                float z[8], c[8], gbv[8], o[8];
                unpack8(rz[k], z); unpack8(rc[k], c); unpack8(rg[k], gbv);
#pragma unroll
                for (int j = 0; j < 8; ++j) { const float hh = z[j] * c[j]; o[j] = gbv[j] * (w0[j] * hm2[j] + w1[j] * hm1[j] + w2[j] * hh); hm2[j] = hm1[j]; hm1[j] = hh; }
                *(u32x4*)(Yc + (size_t)(tl0 + i0 + k) * D + 384 + ch) = pack8(o);
            }
        }
    }
    __syncthreads();
    {
        const int t0 = 16 * wid, nks = (wid >> 1) + 1, t = t0 + fr;
        const bf16_t* up = Pc + (size_t)t * DINP + OFF_UA + 8 * fq;
        bf16_t* yp = Yc + (size_t)t * D + 8 * fq;
#pragma unroll 2
        for (int h = 0; h < 6; ++h) {
            const LAS unsigned char* buf = lds + h * VNT_BYTES;
            u32x4 uu[2];
#pragma unroll
            for (int k = 0; k < 2; ++k) uu[k] = *(const u32x4*)(up + h * 64 + 32 * k);
            const float bs = sgub[h * 128 + t];
            f32x4 acc[4];
#pragma unroll
            for (int n = 0; n < 4; ++n) acc[n] = (f32x4){0.f, 0.f, 0.f, 0.f};
            const bf16_t* Wr = sguw + h * 16384 + (t0 + fr) * 128 + 8 * fq;
            for (int ks = 0; ks < nks; ++ks) {
                const bf16x8 af = *(const bf16x8*)(Wr + ks * 32);
#pragma unroll
                for (int n = 0; n < 4; ++n) {
                    const bf16x8 bfr = *(const LAS bf16x8*)(buf + (32 * (n >> 1) + 8 * (fr >> 2) + 4 * (n & 1) + (fr & 3)) * VNT_STRIDE + (ks * 32 + 8 * fq) * 2);
                    acc[n] = __builtin_amdgcn_mfma_f32_16x16x32_bf16(bfr, af, acc[n], 0, 0, 0);
                }
            }
#pragma unroll
            for (int k = 0; k < 2; ++k) {
                const f32x2 ga = gelu_pk((f32x2){bf_lo(uu[k].x), bf_hi(uu[k].x)}), gb = gelu_pk((f32x2){bf_lo(uu[k].y), bf_hi(uu[k].y)});
                const f32x2 gc = gelu_pk((f32x2){bf_lo(uu[k].z), bf_hi(uu[k].z)}), gd = gelu_pk((f32x2){bf_lo(uu[k].w), bf_hi(uu[k].w)});
                u32x4 w; w.x = cvt_pk_bf16(ga.x * (acc[2 * k][0] + bs), ga.y * (acc[2 * k][1] + bs)); w.y = cvt_pk_bf16(gb.x * (acc[2 * k][2] + bs), gb.y * (acc[2 * k][3] + bs));
                w.z = cvt_pk_bf16(gc.x * (acc[2 * k + 1][0] + bs), gc.y * (acc[2 * k + 1][1] + bs)); w.w = cvt_pk_bf16(gd.x * (acc[2 * k + 1][2] + bs), gd.y * (acc[2 * k + 1][3] + bs));
                *(u32x4*)(yp + h * 64 + 32 * k) = w;
            }
        }
    }
    {
        const int G = T0 + 16 * wid + fr, pos = G & (SEQ - 1);
        bf16_t* Yrow = Yc + (size_t)(16 * wid + fr) * D;
        pool_group<0>(ws, Yrow, wpT, G, pos, fr, fq); pool_group<1>(ws, Yrow, wpT, G, pos, fr, fq); pool_group<2>(ws, Yrow, wpT, G, pos, fr, fq); pool_group<3>(ws, Yrow, wpT, G, pos, fr, fq);
    }
    __syncthreads();
}

__device__ __forceinline__ float wave_sum(float v) {
#pragma unroll
    for (int o = 1; o < 64; o <<= 1) v += __shfl_xor(v, o);
    return v;
}
__device__ __forceinline__ void transpose_item(const float* __restrict__ W, const float* __restrict__ gain, int K, int N, bf16_t* __restrict__ WT, LAS float* scr, int item, int lane) {
    const int nblk = N / 32, kb = item / nblk, nb = item % nblk, k0 = 64 * kb, n0 = 32 * nb;
#pragma unroll
    for (int i = 0; i < 32; ++i) { const int kk = 2 * i + (lane >> 5); const float gsc = gain ? gain[k0 + kk] : 1.0f; scr[kk * 33 + (lane & 31)] = W[(size_t)(k0 + kk) * N + n0 + (lane & 31)] * gsc; }
    asm volatile("s_waitcnt lgkmcnt(0)" ::: "memory");
    const int c = lane & 7;
#pragma unroll
    for (int j = 0; j < 4; ++j) { const int n = (lane >> 3) + 8 * j; const LAS float* s = scr + (8 * c) * 33 + n;
        u32x4 o; o.x = cvt_pk_bf16(s[0 * 33], s[1 * 33]); o.y = cvt_pk_bf16(s[2 * 33], s[3 * 33]); o.z = cvt_pk_bf16(s[4 * 33], s[5 * 33]); o.w = cvt_pk_bf16(s[6 * 33], s[7 * 33]);
        *(u32x4*)(WT + (size_t)(n0 + n) * K + k0 + 8 * c) = o; }
    asm volatile("s_waitcnt lgkmcnt(0)" ::: "memory");
}


#define XB_TMO      128
#define XB_XCNT(j)  (256  + 64 * (j))
#define XB_XSUB(j)  (1280 + 64 * (j))
#define XB_XGEN(j)  (2304 + 64 * (j))
#define XB_TOP      3328
#define XB_TOPGEN   3392
#define XCD_BAR_WORDS 3456
#define XB_SPIN_CAP (1u << 22)
__device__ __forceinline__ unsigned xb_ld(unsigned* p)              { return __hip_atomic_load(p, __ATOMIC_RELAXED, __HIP_MEMORY_SCOPE_AGENT); }
__device__ __forceinline__ unsigned xb_add(unsigned* p, unsigned v) { return __hip_atomic_fetch_add(p, v, __ATOMIC_RELAXED, __HIP_MEMORY_SCOPE_AGENT); }
__device__ __forceinline__ unsigned xb_xcc_id() { return (unsigned)__builtin_amdgcn_s_getreg((3 << 11) | 20) & 0xFu; }
#define XB_SPIN(cond, bar) do { unsigned _sp = 0; while (cond) { __builtin_amdgcn_s_sleep(1); \
    if ((++_sp & 255u) == 0u) { if (xb_ld(&(bar)[XB_TMO])) break; if (_sp > XB_SPIN_CAP) { atomicAdd(&(bar)[XB_TMO], 1u); break; } } } } while (0)
struct XcdBarrier { unsigned* bar; unsigned x; volatile LAS unsigned* st; };
__device__ __forceinline__ XcdBarrier xcd_barrier_post(unsigned* bar, volatile LAS unsigned* st) {
    XcdBarrier b; b.bar = bar; b.x = xb_xcc_id(); b.st = st;
    if (threadIdx.x == 0) st[2] = xb_add(&bar[XB_XCNT(b.x)], 1u);
    return b;
}
__device__ __forceinline__ void xcd_barrier_complete(unsigned* bar, unsigned x, unsigned& nloc, unsigned& nx) {
    const unsigned G = gridDim.x * gridDim.y * gridDim.z;
    unsigned sum, cnt, mine, sp = 0u;
    for (;;) {
        sum = 0u; cnt = 0u; mine = 0u;
#pragma unroll
        for (unsigned j = 0; j < 16; ++j) { const unsigned c = xb_ld(&bar[XB_XCNT(j)]); sum += c; cnt += (c > 0u) ? 1u : 0u; mine = (j == x) ? c : mine; }
        if (sum == G) break;
        __builtin_amdgcn_s_sleep(1);
        if ((++sp & 255u) == 0u) { if (xb_ld(&bar[XB_TMO])) break; if (sp > XB_SPIN_CAP) { atomicAdd(&bar[XB_TMO], 1u); break; } }
    }
    nloc = mine > 0u ? mine : 1u; nx = cnt > 0u ? cnt : 1u;
}
__device__ __forceinline__ void xcd_barrier(const XcdBarrier& b, bool local = false) {
    asm volatile("s_waitcnt vmcnt(0)" ::: "memory");
    __syncthreads();
    if (threadIdx.x == 0) {
        unsigned* bar = b.bar;
        __builtin_amdgcn_s_waitcnt(0);
        unsigned nloc = b.st[0], nx = b.st[1];
        if (nloc == 0u) { xcd_barrier_complete(bar, b.x, nloc, nx); b.st[0] = nloc; b.st[1] = nx; }
        const unsigned old = xb_add(&bar[XB_XSUB(b.x)], 1u);
        const unsigned gen = old / nloc;
        if (local) {
            if (old + 1u == (gen + 1u) * nloc) xb_add(&bar[XB_XGEN(b.x)], 1u);
            else XB_SPIN(xb_ld(&bar[XB_XGEN(b.x)]) == gen, bar);
            __builtin_amdgcn_fence(__ATOMIC_ACQUIRE, "agent");
            asm volatile("s_waitcnt vmcnt(0)" ::: "memory");
        } else if (old + 1u == (gen + 1u) * nloc) {
            __builtin_amdgcn_fence(__ATOMIC_RELEASE, "agent");
            asm volatile("s_waitcnt vmcnt(0)" ::: "memory");
            const unsigned og = xb_add(&bar[XB_TOP], 1u);
            const unsigned tg = og / nx;
            if (og + 1u == (tg + 1u) * nx) xb_add(&bar[XB_TOPGEN], 1u);
            else XB_SPIN(xb_ld(&bar[XB_TOPGEN]) == tg, bar);
            __builtin_amdgcn_fence(__ATOMIC_ACQUIRE, "agent");
            xb_add(&bar[XB_XGEN(b.x)], 1u);
            asm volatile("s_waitcnt vmcnt(0)" ::: "memory");
        } else {
            XB_SPIN(xb_ld(&bar[XB_XGEN(b.x)]) == gen, bar);
            __builtin_amdgcn_fence(__ATOMIC_ACQUIRE, "agent");
            asm volatile("s_waitcnt vmcnt(0)" ::: "memory");
        }
    }
    __syncthreads();
}

struct Args { const float* in[19]; float* out; unsigned char* ws; };

__device__ __forceinline__ void prologue(const Args& a, LAS unsigned char* lds) {
    const int tid = threadIdx.x, wave = __builtin_amdgcn_readfirstlane(tid >> 6), lane = tid & 63;
    const int G = gridDim.x, gw = blockIdx.x * 8 + wave, NGW = G * 8;
    const size_t gt = (size_t)blockIdx.x * 512 + tid, NT = (size_t)G * 512;
    unsigned char* ws = a.ws;
    LAS float* scr = (LAS float*)(lds + wave * 16384);
    constexpr int I_IN = 16 * (DIN / 32), I_OUT = 16 * 32, I_FF1 = 16 * (FF / 32), I_FF2 = 64 * 32, I_G = 16 * 32, I_P = 4 * 32, I_L = I_IN + I_OUT + I_FF1 + I_FF2 + I_G + I_P;
    for (int it = gw; it < DEPTH * I_L; it += NGW) {
        const int l = it / I_L; int r = it % I_L; unsigned char* wl = ws + WS_W + (size_t)l * LW;
        if (r < I_IN) { transpose_item(a.in[3] + (size_t)l * D * DIN, a.in[2] + l * D, D, DIN, (bf16_t*)(wl + LW_IN), scr, r, lane); continue; } r -= I_IN;
        if (r < I_OUT) { transpose_item(a.in[11] + (size_t)l * D * D, nullptr, D, D, (bf16_t*)(wl + LW_OUT), scr, r, lane); continue; } r -= I_OUT;
        if (r < I_FF1) { transpose_item(a.in[13] + (size_t)l * D * FF, a.in[12] + l * D, D, FF, (bf16_t*)(wl + LW_FF1), scr, r, lane); continue; } r -= I_FF1;
        if (r < I_FF2) { transpose_item(a.in[14] + (size_t)l * FF * D, nullptr, FF, D, (bf16_t*)(wl + LW_FF2), scr, r, lane); continue; } r -= I_FF2;
        if (r < I_G) { transpose_item(a.in[16] + (size_t)l * D * D, a.in[15] + l * D, D, D, (bf16_t*)(wl + LW_G), scr, r, lane); continue; } r -= I_G;
        transpose_item(a.in[17] + (size_t)l * DPLE * D, nullptr, DPLE, D, (bf16_t*)(wl + LW_P), scr, r, lane);
    }
    for (size_t i = gt; i < (size_t)DEPTH * 16384; i += NT) { const int l = (int)(i >> 14); const size_t j = i & 16383;
        *(u32x4*)(ws + WS_W + (size_t)l * LW + LW_IN + (size_t)DIN * D * 2 + j * 16) = (u32x4){0u, 0u, 0u, 0u}; }
    for (size_t i = gt; i < (size_t)DEPTH * 6 * 16384; i += NT) { const int l = (int)(i / (6 * 16384)); const int r = (int)(i % (6 * 16384)); const int t = (r >> 7) & 127, s = r & 127;
        const float v = s <= t ? a.in[4][i] : 0.f; ((bf16_t*)(ws + WS_W + (size_t)l * LW + LW_SGU))[r] = (bf16_t)(cvt_pk_bf16(v, 0.f) & 0xffffu); }
    for (size_t i = gt; i < (size_t)DEPTH * 16384; i += NT) { const int l = (int)(i >> 14), r = (int)(i & 16383), g = r >> 12, d = (r >> 6) & 63, c = r & 63;
        const float v = a.in[9][(size_t)l * 16384 + g * 4096 + c * 64 + d] * a.in[10][l * 256 + g * 64 + d];
        ((bf16_t*)(ws + WS_W + (size_t)l * LW + LW_POOL))[r] = (bf16_t)(cvt_pk_bf16(v, 0.f) & 0xffffu); }
    for (size_t i = gt; i < 4 * 768; i += NT) ((float*)(ws + WS_SM_SGUB))[i] = a.in[5][i];
    for (size_t i = gt; i < 4 * 384; i += NT) { ((float*)(ws + WS_SM_LNG))[i] = a.in[6][i]; ((float*)(ws + WS_SM_LNB))[i] = a.in[7][i]; }
    for (size_t i = gt; i < 4 * 1152; i += NT) ((float*)(ws + WS_SM_CONV))[i] = a.in[8][i];
    for (size_t i = gt; i < 1024; i += NT) ((float*)(ws + WS_SM_FG))[i] = a.in[18][i];
    { const f32x4* src = (const f32x4*)a.in[1]; u32x4* dst = (u32x4*)(ws + WS_PB);
      constexpr size_t NIT = (size_t)DEPTH * M * DPLE / 8;
      for (size_t i = gt; i < NIT; i += 4 * NT) { f32x4 v0[4], v1[4];
#pragma unroll
          for (int k = 0; k < 4; ++k) { const size_t ii = i + k * NT < NIT ? i + k * NT : i; v0[k] = src[2 * ii]; v1[k] = src[2 * ii + 1]; }
#pragma unroll
          for (int k = 0; k < 4; ++k) { if (i + k * NT < NIT) { u32x4 w; w.x = cvt_pk_bf16(v0[k][0], v0[k][1]); w.y = cvt_pk_bf16(v0[k][2], v0[k][3]); w.z = cvt_pk_bf16(v1[k][0], v1[k][1]); w.w = cvt_pk_bf16(v1[k][2], v1[k][3]); dst[i + k * NT] = w; } } } }
    { bf16_t* xb = (bf16_t*)(ws + WS_XB); float* ssqp = (float*)(ws + WS_SSQ);
      for (int m0 = gw; m0 < M; m0 += 2 * NGW) {
          f32x4 v[2][4];
#pragma unroll
          for (int r = 0; r < 2; ++r) { const f32x4* xr = (const f32x4*)(a.in[0] + (size_t)(m0 + r * NGW) * D) + lane;
#pragma unroll
              for (int j = 0; j < 4; ++j) v[r][j] = xr[64 * j]; }
#pragma unroll
          for (int r = 0; r < 2; ++r) { const int m = m0 + r * NGW; float s = 0.f; u32x2* o8 = (u32x2*)(xb + (size_t)m * D) + lane;
#pragma unroll
              for (int j = 0; j < 4; ++j) { const f32x4 q = v[r][j]; s += (q[0] * q[0] + q[1] * q[1]) + (q[2] * q[2] + q[3] * q[3]); u32x2 w; w.x = cvt_pk_bf16(q[0], q[1]); w.y = cvt_pk_bf16(q[2], q[3]); o8[64 * j] = w; }
              s = wave_sum(s);
              if (lane < 16) ssqp[(size_t)m * 16 + lane] = lane == 0 ? s : 0.f; } } }
}

__device__ __forceinline__ void final_norm(const Args& a, bool fast, int cid) {
    int tid_ = threadIdx.x; asm volatile("" : "+v"(tid_));
    const int tid = tid_, wave = __builtin_amdgcn_readfirstlane(tid >> 6), lane = tid & 63;
    const int per = M / (int)gridDim.x, NGW = fast ? 8 : (int)gridDim.x * 8, gw = fast ? wave : (int)blockIdx.x * 8 + wave;
    const int mbase = fast ? ((cid & 7) * ((int)gridDim.x / 8) + (cid >> 3)) * per : 0, mend = fast ? mbase + per : M;
    const float* ssqp = (const float*)(a.ws + WS_SSQ); const bf16_t* xb = (const bf16_t*)(a.ws + WS_XB);
    f32x4 gv[2][2];
#pragma unroll
    for (int j = 0; j < 2; ++j) { gv[j][0] = ((const f32x4*)(a.ws + WS_SM_FG))[2 * (lane + 64 * j)]; gv[j][1] = ((const f32x4*)(a.ws + WS_SM_FG))[2 * (lane + 64 * j) + 1]; }
    for (int m = mbase + gw; m < mend; m += NGW) {
        const f32x4* sp = (const f32x4*)(ssqp + (size_t)m * 16);
        const f32x4 s4 = (sp[0] + sp[1]) + (sp[2] + sp[3]);
        const float rs = __builtin_amdgcn_rsqf(((s4[0] + s4[1]) + (s4[2] + s4[3])) * (1.0f / D) + RMS_EPS);
        const u32x4* xr = (const u32x4*)(xb + (size_t)m * D); f32x4* orow = (f32x4*)(a.out + (size_t)m * D);
#pragma unroll
        for (int j = 0; j < 2; ++j) { const u32x4 v = xr[lane + 64 * j];
            orow[2 * (lane + 64 * j)] = (f32x4){bf_lo(v.x), bf_hi(v.x), bf_lo(v.y), bf_hi(v.y)} * rs * gv[j][0];
            orow[2 * (lane + 64 * j) + 1] = (f32x4){bf_lo(v.z), bf_hi(v.z), bf_lo(v.w), bf_hi(v.w)} * rs * gv[j][1]; }
    }
}

__global__ void __launch_bounds__(512, 2) fwd_megakernel(Args a) {
    extern __shared__ __attribute__((aligned(16))) unsigned char lds_raw[];
    LAS unsigned char* lds = (LAS unsigned char*)lds_raw;
    cg::grid_group grid = cg::this_grid();
    const int G = gridDim.x;
#define BARRIER(local_) do { XcdBarrier b_; { size_t z_ = 0; asm volatile("" : "+s"(z_)); b_.bar = (unsigned*)(a.ws + z_) + 4096; } b_.x = xb_xcc_id(); b_.st = (volatile LAS unsigned*)(lds + 131072 + 320) + 8; xcd_barrier(b_, (local_)); } while (0)
#define GRID_SYNC() BARRIER(false)
#define XCD_SYNC() BARRIER(fast)
#define PTRS() size_t z_ = 0; asm volatile("" : "+s"(z_)); unsigned char* ws = a.ws + z_;     \
    int l = l_; asm volatile("" : "+s"(l)); unsigned char* wl = ws + WS_W + (size_t)l * LW; bf16_t* xb = (bf16_t*)(ws + WS_XB); (void)wl; (void)xb;

#ifndef PH
#define PH 0xffff
#endif
    volatile LAS unsigned* MISC = (volatile LAS unsigned*)(lds + 131072 + 320);
    if (threadIdx.x < 32) MISC[threadIdx.x] = 0u;
    __syncthreads();
    if (blockIdx.x == 0) for (int i = threadIdx.x; i < XCD_BAR_WORDS; i += 512) __hip_atomic_store((unsigned*)(a.ws) + 4096 + i, 0u, __ATOMIC_RELAXED, __HIP_MEMORY_SCOPE_AGENT);
    asm volatile("s_waitcnt vmcnt(0)" ::: "memory");
    grid.sync();
    asm volatile("s_waitcnt vmcnt(0)" ::: "memory");
    (void)xcd_barrier_post((unsigned*)(a.ws) + 4096, MISC + 8);
#if PH & 1
    prologue(a, lds);
#endif
    GRID_SYNC();
    bool fast; int cid;
    {
        unsigned* bar = (unsigned*)(a.ws) + 4096; bool ok = (G % 8 == 0) && (G / 8) * 8 == G;
#pragma unroll
        for (int j = 0; j < 16; ++j) { const unsigned cj = xb_ld(&bar[XB_XCNT(j)]); ok = ok && (cj == (j < 8 ? (unsigned)(G / 8) : 0u)); }
        __syncthreads();
        const int xcc = (int)xb_xcc_id(), rank = (int)MISC[10];
        fast = __builtin_amdgcn_readfirstlane(ok ? 1 : 0) != 0;
        cid = __builtin_amdgcn_readfirstlane(fast ? 8 * rank + xcc : (int)blockIdx.x);
    }

#pragma unroll 1
    for (int l_ = 0; l_ < DEPTH; ++l_) {
#if PH & 2
        {
            PTRS();
            pg8::Gemm g{xb, (const bf16_t*)(wl + LW_IN), M, DINP, D, (size_t)16 * 256 * D * 2}; pg8::StaticOrder S; S.init(M, DINP, G, cid);
            pg8::EpiProj<0> E{(bf16_t*)(ws + WS_R1 + SL_PROJ), DINP};
            pg8::gemm_phase<pg8::EpiProj<0>, pg8::StaticOrder, true, true, pg8::RsPre>(lds, g, S, E, pg8::RsPre{ws});
        }
#endif
        GRID_SYNC();
#if PH & 4
        { PTRS();
          const int nch = M / 128;
          for (int c = fast ? (cid & 7) * (nch / 8) + (cid >> 3) : cid; c < nch; c += fast ? nch : G)
            mixer_chunk(lds, c, ws, (const bf16_t*)(wl + LW_SGU), (const float*)(ws + WS_SM_SGUB) + l * 768, (const float*)(ws + WS_SM_LNG) + l * 384, (const float*)(ws + WS_SM_LNB) + l * 384, (const float*)(ws + WS_SM_CONV) + l * 1152, (const bf16_t*)(wl + LW_POOL)); }
#endif
        GRID_SYNC();
#if PH & 8
        {
            PTRS();
            pg8::Gemm g{(const bf16_t*)(ws + WS_R1 + SL_YCAT), (const bf16_t*)(wl + LW_OUT), M, D, D, XS}; pg8::StaticOrder S; S.init(M, D, G, cid);
            pg8::EpiRes<false> E{ws};
            pg8::gemm_phase<pg8::EpiRes<false>, pg8::StaticOrder, true, true>(lds, g, S, E);
        }
#endif
        XCD_SYNC();
#if PH & 16
        {
            PTRS();
            pg8::Gemm g{xb, (const bf16_t*)(wl + LW_FF1), M, FF, D, (size_t)16 * 256 * D * 2}; pg8::StaticOrder S; S.init(M, FF, G, cid);
            pg8::EpiProj<1> E{(bf16_t*)(ws + WS_R1 + SL_HID), FF};
            pg8::gemm_phase<pg8::EpiProj<1>, pg8::StaticOrder, true, true, pg8::RsPre>(lds, g, S, E, pg8::RsPre{ws});
        }
#endif
        XCD_SYNC();
#if PH & 32
        {
            PTRS();
            pg8::Gemm g{(const bf16_t*)(ws + WS_R1 + SL_HID), (const bf16_t*)(wl + LW_FF2), M, D, FF, XS}; pg8::StaticOrder S; S.init(M, D, G, cid);
            pg8::EpiRes<false> E{ws};
            pg8::gemm_phase<pg8::EpiRes<false>, pg8::StaticOrder, true, true>(lds, g, S, E);
        }
#endif
        XCD_SYNC();
#if PH & 64
        {
            PTRS();
            pg8::Gemm g{xb, (const bf16_t*)(wl + LW_G), M, D, D, (size_t)16 * 256 * D * 2}; pg8::StaticOrder S; S.init(M, D, G, cid);
            pg8::EpiGate E{ws};
            pg8::gemm_phase<pg8::EpiGate, pg8::StaticOrder, true, true, pg8::RsPre>(lds, g, S, E, pg8::RsPre{ws});
        }
#endif
        XCD_SYNC();
#if PH & 128
        {
            PTRS();
            pg8::Gemm g{(const bf16_t*)(ws + WS_PB) + (size_t)l * M * DPLE, (const bf16_t*)(wl + LW_P), M, D, DPLE, (size_t)16 * 256 * DPLE * 2}; pg8::StaticOrder S; S.init(M, D, G, cid);
            pg8::EpiRes<true> E{ws};
            pg8::gemm_phase<pg8::EpiRes<true>, pg8::StaticOrder, true, true>(lds, g, S, E);
        }
#endif
        XCD_SYNC();
    }
#if PH & 256
    final_norm(a, fast, cid);
#endif
}

extern "C" void kernel_launch(void* const* d_in, const int* in_sizes, int n_in, void* d_out, int out_size, void* d_ws, size_t ws_size, hipStream_t stream) {
    static int grid_blocks = 0;
    if (grid_blocks == 0) {
        if (n_in != 19 || out_size != M * D || ws_size < WS_END) { fprintf(stderr, "kernel_launch: unexpected shapes (n_in %d out %d ws %zu, need %zu)\n", n_in, out_size, ws_size, (size_t)WS_END); grid_blocks = -1; return; }
        int dev = 0, cus = 0, per_cu = 0;
        hipGetDevice(&dev);
        hipDeviceGetAttribute(&cus, hipDeviceAttributeMultiprocessorCount, dev);
        if (hipFuncSetAttribute((const void*)fwd_megakernel, hipFuncAttributeMaxDynamicSharedMemorySize, LDS_BYTES) != hipSuccess) { fprintf(stderr, "kernel_launch: hipFuncSetAttribute failed\n"); grid_blocks = -1; return; }
        if (hipOccupancyMaxActiveBlocksPerMultiprocessor(&per_cu, (const void*)fwd_megakernel, 512, LDS_BYTES) != hipSuccess || per_cu < 1) { fprintf(stderr, "kernel_launch: occupancy query gave %d\n", per_cu); per_cu = 1; }
        (void)hipGetLastError();
        grid_blocks = cus * 1;
    }
    if (grid_blocks < 0) return;
    Args a{};
    for (int i = 0; i < 19; ++i) a.in[i] = (const float*)d_in[i];
    a.out = (float*)d_out; a.ws = (unsigned char*)d_ws;
    void* args[] = {&a};
    hipError_t e = hipLaunchCooperativeKernel((const void*)fwd_megakernel, dim3(grid_blocks), dim3(512), args, LDS_BYTES, stream);
    if (e != hipSuccess) fprintf(stderr, "cooperative launch failed: %s (grid %d)\n", hipGetErrorString(e), grid_blocks);
}
```

```cpp
#include <hip/hip_runtime.h>
#include <hip/hip_cooperative_groups.h>
#include <cstdio>
#include <cstdint>
namespace cg = cooperative_groups;

#define LAS __attribute__((address_space(3)))
typedef unsigned short bf16_t;
typedef short bf16x8 __attribute__((ext_vector_type(8)));
typedef float f32x4 __attribute__((ext_vector_type(4)));
typedef float f32x2 __attribute__((ext_vector_type(2)));
typedef unsigned u32x4 __attribute__((ext_vector_type(4)));
typedef unsigned u32x2 __attribute__((ext_vector_type(2)));

constexpr int M = 32768, SEQ = 16384, D = 1024, DIN = 2176, DINP = 2304, FF = 4096, DPLE = 256, DEPTH = 4;
constexpr int OFF_UA = 0, OFF_VA = 384, OFF_ZB = 768, OFF_GB = 1152, OFF_GC = 1536, OFF_ZC = 1920;
constexpr float RMS_EPS = 1e-6f, LN_EPS = 1e-5f;

constexpr size_t MiB = 1u << 20, KiB = 1u << 10;
constexpr size_t WS_W = 1 * MiB, LW = 26 * MiB;
constexpr size_t LW_IN = 0, LW_OUT = 4608 * KiB, LW_FF1 = LW_OUT + 2 * MiB, LW_FF2 = LW_FF1 + 8 * MiB, LW_G = LW_FF2 + 8 * MiB, LW_P = LW_G + 2 * MiB,
                 LW_SGU = LW_P + 512 * KiB, LW_POOL = LW_SGU + 192 * KiB;
static_assert(LW_POOL + 32 * KiB <= LW, "layer weights");
constexpr size_t WS_XB = WS_W + 4 * LW;
constexpr size_t WS_PB = WS_XB + 64 * MiB;
constexpr size_t WS_SSQ = WS_PB + 64 * MiB;
constexpr size_t WS_R1 = WS_SSQ + 2 * MiB;
constexpr size_t XS = 32 * MiB, SL_PROJ = 0, SL_YCAT = 18 * MiB, SL_HID = 0, SL_GATE = 0;
__device__ __forceinline__ size_t slice_off(int row) { return WS_R1 + (size_t)(row >> 12) * XS; }
constexpr size_t WS_SSQ2 = WS_R1 + 256 * MiB;
constexpr size_t WS_END = WS_SSQ2 + 2 * MiB;

constexpr size_t WS_PANEL = 64 * KiB;
constexpr size_t WS_SM_SGUB = 128 * KiB, WS_SM_LNG = 144 * KiB, WS_SM_LNB = 160 * KiB, WS_SM_CONV = 176 * KiB, WS_SM_FG = 208 * KiB;
constexpr int LDS_BYTES = 147456;
static_assert(DEPTH % 2 == 0, "the residual ping-pong must end in the d_ws buffer (the final norm writes d_out)");

typedef __bf16 bf16x2_t __attribute__((ext_vector_type(2)));
__device__ __forceinline__ unsigned cvt_pk_bf16(float lo, float hi) { const f32x2 v = {lo, hi}; return __builtin_bit_cast(unsigned, __builtin_convertvector(v, bf16x2_t)); }
__device__ __forceinline__ float bf_lo(unsigned w) { return __uint_as_float(w << 16); }
__device__ __forceinline__ float bf_hi(unsigned w) { return __uint_as_float(w & 0xffff0000u); }
__device__ __forceinline__ f32x2 gelu_pk(f32x2 v) {
    const f32x2 av = __builtin_elementwise_abs(v), d = av * 0.2316418882f + 1.0f;
    f32x2 t; t.x = __builtin_amdgcn_rcpf(d.x); t.y = __builtin_amdgcn_rcpf(d.y);
    f32x2 q = t * 0.5307027145f + (-0.7265760135f); q = q * t + 0.7107068705f; q = q * t + (-0.142248368f); q = q * t + 0.127414796f; q = q * t;
    const f32x2 s = (v * v) * (-0.72134752044f);
    f32x2 e; e.x = __builtin_amdgcn_exp2f(s.x); e.y = __builtin_amdgcn_exp2f(s.y);
    const f32x2 m = v * (q * e), r = v - m;
    f32x2 o; o.x = v.x < 0.f ? m.x : r.x; o.y = v.y < 0.f ? m.y : r.y; return o;
}

namespace pg8 {
constexpr int BM = 256, BK = 64, HALF = 128, HTB = HALF * BK * 2, STAGE_BYTES = 8 * HTB, NXCD = 8, WGM = 8;
__host__ __device__ __forceinline__ int lds_byte(int r, int c) { const int st = (r >> 4) * 2 + (c >> 5), rr = r & 15, cc = c & 31, ob = rr * 64 + cc * 2; return st * 1024 + (ob ^ (((ob >> 9) & 1) << 5)); }
__host__ __device__ __forceinline__ void stage_rc(int b, int& R, int& C) { const int st = b / 1024, sb = b % 1024, swz = sb ^ (((sb >> 9) & 1) << 5); R = (st >> 1) * 16 + swz / 64; C = (st & 1) * 32 + (swz % 64) / 2; }
__host__ __device__ __forceinline__ int perm32(int rho) { const int n = rho >> 4, i = rho & 15; return 8 * (i >> 2) + 4 * n + (i & 3); }

struct Unit { int pm, pn; };
struct Gemm { const bf16_t* A; const bf16_t* Bt; int M, N, K; size_t axs; };

struct StaticOrder {
    int nM, nN, nwg, G, c;
    __host__ __device__ void init(int M_, int N_, int G_, int c_) { nM = M_ / BM; nN = N_ / BM; nwg = nM * nN; G = G_; c = c_; }
    __host__ __device__ bool next(int i, Unit& u) const {
        const long L = (long)i * G + c; if (L >= nwg) return false;
        int wgid = (int)L; { const int q = nwg / NXCD, r = nwg % NXCD, xcd = wgid % NXCD, off = wgid / NXCD; wgid = (xcd < r ? xcd * (q + 1) : r * (q + 1) + (xcd - r) * q) + off; }
        const int nig = WGM * nN, gid = wgid / nig, fm = gid * WGM, gsz = (nM - fm) < WGM ? (nM - fm) : WGM;
        u.pm = fm + ((wgid % nig) % gsz); u.pn = (wgid % nig) / gsz; return true;
    }
    __device__ __forceinline__ void a_ready(const Unit&) const {}
    __device__ __forceinline__ void done(const Unit&) const {}
};

constexpr int RSL_OFF = 131072 + 1024;
template <class Sched, bool SYNC = true> __device__ __forceinline__ void fill_rs(LAS unsigned char* lds, const Sched& S, const float* ssqp) {
    int tid_ = threadIdx.x; asm volatile("" : "+v"(tid_));
    LAS float* rsl = (LAS float*)(lds + RSL_OFF);
    const int half = tid_ >> 8, r = tid_ & 255;
    Unit u;
    for (int i = half; S.next(i, u); i += 2) {
        const f32x4* sp = (const f32x4*)(ssqp + (unsigned)(u.pm * BM + r) * 16);
        const f32x4 s4 = (sp[0] + sp[1]) + (sp[2] + sp[3]);
        rsl[i * 256 + r] = __builtin_amdgcn_rsqf(((s4[0] + s4[1]) + (s4[2] + s4[3])) * (1.0f / D) + RMS_EPS);
    }
    if (SYNC) __syncthreads();
}
struct NoPre { template <class Sched> __device__ __forceinline__ void operator()(LAS unsigned char*, const Sched&) const {} };
struct RsPre { const float* ssqp; template <class Sched> __device__ __forceinline__ void operator()(LAS unsigned char* lds, const Sched& S) const { fill_rs<Sched, false>(lds, S, ssqp); } };
template <int N> __device__ __forceinline__ void wait_vm() { asm volatile("s_waitcnt vmcnt(%0)" :: "n"(N) : "memory"); }
template <int ACT> struct EpiProj {
    static constexpr bool PERM = true, AFTER_DRAIN = false; static constexpr int NST = 16;
    bf16_t* O; int ldc;
    __device__ __forceinline__ void operator()(const f32x4 (&acc)[2][2][4][2], const Unit& u, int ui, LAS unsigned char* lds, int wr, int wc, int fr, int fq) const {
        const LAS float* rsl = (const LAS float*)(lds + RSL_OFF) + ui * 256 + wr * 64 + fr;
        const int row0 = (u.pm & 15) * BM + wr * 64 + fr, col0 = u.pn * BM + wc * 32 + 8 * fq; bf16_t* Os = O + (size_t)(u.pm >> 4) * (XS / 2);
#pragma unroll
        for (int ai = 0; ai < 2; ++ai)
#pragma unroll
            for (int m = 0; m < 4; ++m) {
                const int row = row0 + ai * HALF + m * 16; const float rs = rsl[ai * HALF + m * 16];
                bf16_t* rowp = Os + (size_t)row * ldc + col0;
#pragma unroll
                for (int bj = 0; bj < 2; ++bj) {
                    if (ACT == 0 && bj == 1 && u.pn * BM + HALF >= DIN) continue;
                    f32x4 v0 = acc[ai][bj][m][0] * rs, v1 = acc[ai][bj][m][1] * rs;
                    if (ACT == 1) {
#pragma unroll
                        for (int j = 0; j < 4; ++j) { const float a = fmaxf(v0[j], 0.f), b = fmaxf(v1[j], 0.f); v0[j] = a * a; v1[j] = b * b; }
                    }
                    u32x4 w; w.x = cvt_pk_bf16(v0[0], v0[1]); w.y = cvt_pk_bf16(v0[2], v0[3]); w.z = cvt_pk_bf16(v1[0], v1[1]); w.w = cvt_pk_bf16(v1[2], v1[3]);
                    *(u32x4*)(rowp + bj * HALF) = w;
                }
            }
    }
};
struct EpiPle {
    static constexpr bool PERM = true, AFTER_DRAIN = false; static constexpr int NST = 16;
    unsigned char* ws;
    __device__ __forceinline__ void operator()(const f32x4 (&acc)[2][2][4][2], const Unit& u, int ui, LAS unsigned char* lds, int wr, int wc, int fr, int fq) const {
        bf16_t* ple = (bf16_t*)(ws + WS_R1 + (size_t)(u.pm >> 4) * XS + SL_GATE);
        const int row0 = (u.pm & 15) * BM + wr * 64 + fr, col0 = u.pn * BM + wc * 32 + 8 * fq;
#pragma unroll
        for (int ai = 0; ai < 2; ++ai)
#pragma unroll
            for (int m = 0; m < 4; ++m) {
                const unsigned off = (unsigned)(row0 + ai * HALF + m * 16) * D + col0;
#pragma unroll
                for (int bj = 0; bj < 2; ++bj) { const f32x4 v0 = acc[ai][bj][m][0], v1 = acc[ai][bj][m][1];
                    u32x4 w; w.x = cvt_pk_bf16(v0[0], v0[1]); w.y = cvt_pk_bf16(v0[2], v0[3]); w.z = cvt_pk_bf16(v1[0], v1[1]); w.w = cvt_pk_bf16(v1[2], v1[3]);
                    *(u32x4*)(ple + off + bj * HALF) = w; }
            }
    }
};
template <bool GATED> struct EpiRes {
    static constexpr bool PERM = true, AFTER_DRAIN = false; static constexpr int NST = 24;
    const bf16_t* xsrc; bf16_t* xdst; float* ssqp; unsigned char* ws; unsigned target;
    __device__ __forceinline__ void operator()(const f32x4 (&acc)[2][2][4][2], const Unit& u, int ui, LAS unsigned char* lds, int wr, int wc, int fr, int fq) const {
        const LAS float* rsl = (const LAS float*)(lds + RSL_OFF) + ui * 256 + wr * 64 + fr;
        const int row0 = u.pm * BM + wr * 64 + fr, col0 = u.pn * BM + wc * 32 + 8 * fq;
        const bf16_t* ple = GATED ? (const bf16_t*)(ws + WS_R1 + (size_t)(u.pm >> 4) * XS + SL_GATE) - (size_t)(u.pm >> 4) * 4096 * D : nullptr;
        if (GATED) {
            if (threadIdx.x == 0) { unsigned* cnt = (unsigned*)(ws + WS_PANEL) + 64 * u.pm;
                __hip_atomic_fetch_add(cnt, 1u, __ATOMIC_RELAXED, __HIP_MEMORY_SCOPE_AGENT);
                unsigned sp = 0; while (__hip_atomic_load(cnt, __ATOMIC_RELAXED, __HIP_MEMORY_SCOPE_AGENT) < target) { __builtin_amdgcn_s_sleep(1); if (++sp > (1u << 22)) break; } }
            asm volatile("" ::: "memory"); __builtin_amdgcn_s_barrier(); asm volatile("" ::: "memory");
        }
#pragma unroll
        for (int ai = 0; ai < 2; ++ai) {
            u32x4 b[4][2], g[4][2];
#pragma unroll
            for (int m = 0; m < 4; ++m) { const unsigned off = (unsigned)(row0 + ai * HALF + m * 16) * D + col0;
#pragma unroll
                for (int bj = 0; bj < 2; ++bj) { const unsigned c = off + bj * HALF; b[m][bj] = *(const u32x4*)(xsrc + c); if (GATED) g[m][bj] = *(const u32x4*)(ple + c); } }
#pragma unroll
            for (int m = 0; m < 4; ++m) { const int row = row0 + ai * HALF + m * 16; const unsigned off = (unsigned)row * D + col0; float q = 0.f;
                const float rs = GATED ? rsl[ai * HALF + m * 16] : 1.0f;
#pragma unroll
                for (int bj = 0; bj < 2; ++bj) { const unsigned c = off + bj * HALF; f32x4 a0 = acc[ai][bj][m][0], a1 = acc[ai][bj][m][1];
                    if (GATED) { a0 = a0 * rs; a1 = a1 * rs;
#pragma unroll
                        for (int j = 0; j < 4; ++j) { a0[j] = __builtin_amdgcn_rcpf(1.0f + __builtin_amdgcn_exp2f(-1.44269504089f * a0[j])); a1[j] = __builtin_amdgcn_rcpf(1.0f + __builtin_amdgcn_exp2f(-1.44269504089f * a1[j])); }
                        const u32x4 gg = g[m][bj]; a0[0] *= bf_lo(gg.x); a0[1] *= bf_hi(gg.x); a0[2] *= bf_lo(gg.y); a0[3] *= bf_hi(gg.y); a1[0] *= bf_lo(gg.z); a1[1] *= bf_hi(gg.z); a1[2] *= bf_lo(gg.w); a1[3] *= bf_hi(gg.w); }
                    const u32x4 bb = b[m][bj];
                    const f32x4 o0 = (f32x4){bf_lo(bb.x), bf_hi(bb.x), bf_lo(bb.y), bf_hi(bb.y)} + a0, o1 = (f32x4){bf_lo(bb.z), bf_hi(bb.z), bf_lo(bb.w), bf_hi(bb.w)} + a1;
                    u32x4 w; w.x = cvt_pk_bf16(o0[0], o0[1]); w.y = cvt_pk_bf16(o0[2], o0[3]); w.z = cvt_pk_bf16(o1[0], o1[1]); w.w = cvt_pk_bf16(o1[2], o1[3]); *(u32x4*)(xdst + c) = w;
                    q += ((o0[0] * o0[0] + o0[1] * o0[1]) + (o0[2] * o0[2] + o0[3] * o0[3])) + ((o1[0] * o1[0] + o1[1] * o1[1]) + (o1[2] * o1[2] + o1[3] * o1[3])); }
                q += __shfl_xor(q, 16); q += __shfl_xor(q, 32);
                if (fq == 0) ssqp[(unsigned)row * 16 + u.pn * 4 + wc] = q; }
            asm volatile("" ::: "memory");
        }
    }
};

template <class Epi, class Sched, bool ALIGN_EPI = false, bool SP2 = false, class Pre = NoPre>
__device__ __forceinline__ void gemm_phase(LAS unsigned char* lds, const Gemm g, const Sched& S, const Epi& E, const Pre& pre = Pre()) {
    int tid_ = threadIdx.x; asm volatile("" : "+v"(tid_));
    const int tid = tid_, wid = __builtin_amdgcn_readfirstlane(tid >> 6), lane = tid & 63, wr = wid >> 2, wc = wid & 3, fr = lane & 15, fq = lane >> 4;
    int K_ = g.K; asm volatile("" : "+s"(K_));
    const int K = K_, nt = K / BK;
    unsigned voffA[2], voffB[2];
#pragma unroll
    for (int i = 0; i < 2; ++i) { int R, C; stage_rc(tid * 16 + i * 8192, R, C); const int Rb = Epi::PERM ? ((R & ~31) + perm32(R & 31)) : R;
        voffA[i] = (unsigned)(R * K + C) * 2u; voffB[i] = (unsigned)(Rb * K + C) * 2u; }
    const size_t kstep = (size_t)(BK * 2);
    const size_t hstep = (size_t)HALF * K * 2;
    const size_t tstep = 2 * hstep;
    const unsigned ldsw = (unsigned)wid * 1024u;
    const int aoff = lds_byte(wr * 64 + fr, fq * 8), boff = lds_byte(wc * 32 + fr, fq * 8);
#define PG8_SA(b, h) (((b) * 2 + (h)) * HTB)
#define PG8_SB(b, h) ((4 + (b) * 2 + (h)) * HTB)
#define PG8_STAGE(bufoff, gbase, voff) do { _Pragma("unroll") for (int _i = 0; _i < 2; ++_i) \
        __builtin_amdgcn_global_load_lds((const unsigned*)((const char*)(gbase) + (voff)[_i]), (LAS unsigned*)(lds + (bufoff) + ldsw + _i * 8192), 16, 0, 0); } while (0)
#define PG8_LDA(dst, b, h) do { _Pragma("unroll") for (int m = 0; m < 4; ++m) _Pragma("unroll") for (int k = 0; k < 2; ++k) dst[m][k] = *(const LAS bf16x8*)(lds + PG8_SA(b, h) + aoff + m * 2048 + k * 1024); } while (0)
#define PG8_LDB(dst, b, h) do { _Pragma("unroll") for (int n = 0; n < 2; ++n) _Pragma("unroll") for (int k = 0; k < 2; ++k) dst[n][k] = *(const LAS bf16x8*)(lds + PG8_SB(b, h) + boff + n * 2048 + k * 1024); } while (0)
#define PG8_MMA(ai, bj, At, Bt) do { __builtin_amdgcn_s_setprio(1); _Pragma("unroll") for (int m = 0; m < 4; ++m) _Pragma("unroll") for (int n = 0; n < 2; ++n) _Pragma("unroll") for (int k = 0; k < 2; ++k) \
        acc[ai][bj][m][n] = __builtin_amdgcn_mfma_f32_16x16x32_bf16(Bt[n][k], At[m][k], acc[ai][bj][m][n], 0, 0, 0); __builtin_amdgcn_s_setprio(0); } while (0)
#define PG8_WAIT_V(n) asm volatile("s_waitcnt vmcnt(" #n ")" ::: "memory")
#define PG8_WAIT_L(n) asm volatile("s_waitcnt lgkmcnt(" #n ")" ::: "memory")
#define PG8_BAR __builtin_amdgcn_s_barrier()
#define PG8_SCHED __builtin_amdgcn_sched_barrier(0)
    Unit cur, nxt; int ui = 0;
    if (!S.next(0, cur)) return;
    f32x4 acc[2][2][4][2];
#pragma unroll
    for (int a = 0; a < 2; ++a)
#pragma unroll
        for (int b = 0; b < 2; ++b)
#pragma unroll
            for (int m = 0; m < 4; ++m)
#pragma unroll
                for (int n = 0; n < 2; ++n) acc[a][b][m][n] = (f32x4){0.f, 0.f, 0.f, 0.f};
    bf16x8 At[4][2], B0[2][2], B1[2][2];
    const char* cA = (const char*)g.A + (size_t)(cur.pm >> 4) * g.axs + (size_t)(cur.pm & 15) * tstep; const char* cB = (const char*)g.Bt + (size_t)cur.pn * tstep;
    S.a_ready(cur);
    if constexpr (SP2) {
        PG8_STAGE(PG8_SB(0, 0), cB, voffB); PG8_STAGE(PG8_SB(0, 1), cB + hstep, voffB); PG8_STAGE(PG8_SA(0, 0), cA, voffA); PG8_STAGE(PG8_SA(0, 1), cA + hstep, voffA);
        if (wr == 1) PG8_BAR;
        PG8_WAIT_V(2); PG8_BAR;
        PG8_STAGE(PG8_SB(1, 0), cB + kstep, voffB); PG8_STAGE(PG8_SA(1, 0), cA + kstep, voffA); PG8_STAGE(PG8_SB(1, 1), cB + hstep + kstep, voffB);
        pre(lds, S);
        PG8_WAIT_V(6); PG8_BAR;
    } else {
        PG8_STAGE(PG8_SB(0, 0), cB, voffB); PG8_STAGE(PG8_SA(0, 0), cA, voffA); PG8_STAGE(PG8_SB(0, 1), cB + hstep, voffB); PG8_STAGE(PG8_SA(0, 1), cA + hstep, voffA);
        if (wr == 1) PG8_BAR;
        PG8_WAIT_V(4); PG8_BAR;
        PG8_STAGE(PG8_SB(1, 0), cB + kstep, voffB); PG8_STAGE(PG8_SA(1, 0), cA + kstep, voffA); PG8_STAGE(PG8_SB(1, 1), cB + hstep + kstep, voffB);
        PG8_WAIT_V(6); PG8_BAR;
    }
    for (;;) {
        const bool has_next = S.next(ui + 1, nxt);
        const char* nA = has_next ? (const char*)g.A + (size_t)(nxt.pm >> 4) * g.axs + (size_t)(nxt.pm & 15) * tstep : cA; const char* nB = has_next ? (const char*)g.Bt + (size_t)nxt.pn * tstep : cB;
        for (int t = 0; t < nt; t += 2) {
            const bool last = (t == nt - 2);
            const char* a1 = cA + (size_t)(t + 1) * kstep;
            const char* a2 = last ? nA : cA + (size_t)(t + 2) * kstep; const char* b2 = last ? nB : cB + (size_t)(t + 2) * kstep;
            const char* a3 = a2 + kstep; const char* b3 = b2 + kstep;
            if (last && has_next) S.a_ready(nxt);
            if constexpr (SP2) {
            PG8_LDB(B0, 0, 0); PG8_LDB(B1, 0, 1); PG8_SCHED; PG8_LDA(At, 0, 0); PG8_STAGE(PG8_SA(1, 1), a1 + hstep, voffA);
            PG8_WAIT_V(8);
            PG8_WAIT_L(0); PG8_BAR; PG8_MMA(0, 0, At, B0); PG8_MMA(0, 1, At, B1); PG8_BAR; PG8_SCHED;
            PG8_LDA(At, 0, 1); PG8_STAGE(PG8_SB(0, 0), b2, voffB); PG8_STAGE(PG8_SB(0, 1), b2 + hstep, voffB); PG8_STAGE(PG8_SA(0, 0), a2, voffA);
            PG8_WAIT_V(8);
            PG8_WAIT_L(0); PG8_BAR; PG8_MMA(1, 0, At, B0); PG8_MMA(1, 1, At, B1); PG8_BAR; PG8_SCHED;
            PG8_LDB(B0, 1, 0); PG8_LDB(B1, 1, 1); PG8_SCHED; PG8_LDA(At, 1, 0); PG8_STAGE(PG8_SA(0, 1), a2 + hstep, voffA);
            PG8_WAIT_V(8); PG8_WAIT_L(0); PG8_BAR; PG8_MMA(0, 0, At, B0); PG8_MMA(0, 1, At, B1); PG8_BAR; PG8_SCHED;
            PG8_LDA(At, 1, 1); PG8_STAGE(PG8_SB(1, 0), b3, voffB); PG8_STAGE(PG8_SB(1, 1), b3 + hstep, voffB); PG8_STAGE(PG8_SA(1, 0), a3, voffA);
            PG8_WAIT_V(8); PG8_WAIT_L(0); PG8_BAR; PG8_MMA(1, 0, At, B0); PG8_MMA(1, 1, At, B1); PG8_BAR; PG8_SCHED;
            } else {
            PG8_LDB(B0, 0, 0); PG8_SCHED; PG8_LDA(At, 0, 0); PG8_STAGE(PG8_SA(1, 1), a1 + hstep, voffA);
            PG8_WAIT_L(8); PG8_BAR; PG8_WAIT_L(0); PG8_MMA(0, 0, At, B0); PG8_BAR; PG8_SCHED;
            PG8_LDB(B1, 0, 1); PG8_STAGE(PG8_SB(0, 0), b2, voffB);
            PG8_BAR; PG8_WAIT_L(0); PG8_MMA(0, 1, At, B1); PG8_BAR;
            PG8_LDA(At, 0, 1); PG8_STAGE(PG8_SA(0, 0), a2, voffA);
            PG8_BAR; PG8_WAIT_L(0); PG8_MMA(1, 0, At, B0); PG8_BAR; PG8_SCHED;
            PG8_STAGE(PG8_SB(0, 1), b2 + hstep, voffB);
            PG8_WAIT_V(6); PG8_BAR; PG8_MMA(1, 1, At, B1); PG8_BAR;
            PG8_LDB(B0, 1, 0); PG8_SCHED; PG8_LDA(At, 1, 0); PG8_STAGE(PG8_SA(0, 1), a2 + hstep, voffA);
            PG8_WAIT_L(8); PG8_BAR; PG8_WAIT_L(0); PG8_MMA(0, 0, At, B0); PG8_BAR; PG8_SCHED;
            PG8_LDB(B1, 1, 1); PG8_STAGE(PG8_SB(1, 0), b3, voffB);
            PG8_BAR; PG8_WAIT_L(0); PG8_MMA(0, 1, At, B1); PG8_BAR;
            PG8_LDA(At, 1, 1); PG8_STAGE(PG8_SA(1, 0), a3, voffA);
            PG8_BAR; PG8_WAIT_L(0); PG8_MMA(1, 0, At, B0); PG8_BAR; PG8_SCHED;
            PG8_STAGE(PG8_SB(1, 1), b3 + hstep, voffB);
            PG8_WAIT_V(6); PG8_BAR; PG8_MMA(1, 1, At, B1); PG8_BAR;
            }
        }
        if constexpr (ALIGN_EPI) { if (wr == 0) PG8_BAR; }
        E(acc, cur, ui, lds, wr, wc, fr, fq); S.done(cur);
        if (!has_next) break;
#pragma unroll
        for (int a = 0; a < 2; ++a)
#pragma unroll
            for (int b = 0; b < 2; ++b)
#pragma unroll
                for (int m = 0; m < 4; ++m)
#pragma unroll
                    for (int n = 0; n < 2; ++n) acc[a][b][m][n] = (f32x4){0.f, 0.f, 0.f, 0.f};
        cur = nxt; cA = nA; cB = nB; ++ui;
        if constexpr (ALIGN_EPI) { if (wr == 1) PG8_BAR; }
    }
    PG8_WAIT_V(0);
    if constexpr (!ALIGN_EPI) { if (wr == 0) PG8_BAR; }
    PG8_BAR;
#undef PG8_SA
#undef PG8_SB
#undef PG8_STAGE
#undef PG8_LDA
#undef PG8_LDB
#undef PG8_MMA
#undef PG8_WAIT_V
#undef PG8_WAIT_L
#undef PG8_BAR
#undef PG8_SCHED
}
}

__device__ __forceinline__ void unpack8(const u32x4 r, float (&f)[8]) {
    f[0] = bf_lo(r.x); f[1] = bf_hi(r.x); f[2] = bf_lo(r.y); f[3] = bf_hi(r.y); f[4] = bf_lo(r.z); f[5] = bf_hi(r.z); f[6] = bf_lo(r.w); f[7] = bf_hi(r.w);
}
__device__ __forceinline__ u32x4 pack8(const float (&f)[8]) {
    u32x4 w; w.x = cvt_pk_bf16(f[0], f[1]); w.y = cvt_pk_bf16(f[2], f[3]); w.z = cvt_pk_bf16(f[4], f[5]); w.w = cvt_pk_bf16(f[6], f[7]); return w;
}
__device__ __forceinline__ void gelu8(float (&f)[8]) {
#pragma unroll
    for (int j = 0; j < 8; j += 2) { const f32x2 r = gelu_pk((f32x2){f[j], f[j + 1]}); f[j] = r.x; f[j + 1] = r.y; }
}

constexpr int VNT_STRIDE = 272, VNT_BYTES = 64 * VNT_STRIDE;
__device__ __forceinline__ const bf16_t* prow(const unsigned char* ws, int row) { return (const bf16_t*)(ws + slice_off(row) + SL_PROJ) + (size_t)(row & 4095) * DINP; }
template <int GRP>
__device__ __forceinline__ void pool_group(const unsigned char* __restrict__ ws, bf16_t* __restrict__ Yrow, const bf16_t* __restrict__ wpT, int G, int pos, int fr, int fq) {
    constexpr int win = 2 << GRP;
    f32x4 acc[4];
#pragma unroll
    for (int n = 0; n < 4; ++n) acc[n] = (f32x4){0.f, 0.f, 0.f, 0.f};
    const int cnt = (pos + 1) < win ? (pos + 1) : win;
    const float inv = 1.0f / (float)cnt;
#pragma unroll
    for (int ks = 0; ks < 2; ++ks) {
        const int c = GRP * 64 + ks * 32 + 8 * fq;
        constexpr int NB = win < 8 ? win : 8;
        bf16x8 bfr[4];
#pragma unroll
        for (int n = 0; n < 4; ++n) bfr[n] = *(const bf16x8*)(wpT + GRP * 4096 + (32 * (n >> 1) + 8 * (fr >> 2) + 4 * (n & 1) + (fr & 3)) * 64 + ks * 32 + 8 * fq);
        float s[8], z0[8];
#pragma unroll
        for (int j = 0; j < 8; ++j) { s[j] = 0.f; z0[j] = 0.f; }
#pragma unroll
        for (int j0 = 0; j0 < win; j0 += NB) {
            u32x4 r[NB];
#pragma unroll
            for (int jj = 0; jj < NB; ++jj) r[jj] = *(const u32x4*)(prow(ws, G - ((j0 + jj) < cnt ? (j0 + jj) : 0)) + OFF_ZC + c);
#pragma unroll
            for (int jj = 0; jj < NB; ++jj) { float v[8]; unpack8(r[jj], v); const float mk = (j0 + jj) < cnt ? 1.f : 0.f;
#pragma unroll
                for (int j = 0; j < 8; ++j) { s[j] += mk * v[j]; if (j0 + jj == 0) z0[j] = v[j]; } }
            if (j0 + NB < win) asm volatile("" ::: "memory");
        }
        float pl[8];
#pragma unroll
        for (int j = 0; j < 8; ++j) pl[j] = s[j] * inv - z0[j];
        const bf16x8 af = __builtin_bit_cast(bf16x8, pack8(pl));
#pragma unroll
        for (int n = 0; n < 4; ++n) acc[n] = __builtin_amdgcn_mfma_f32_16x16x32_bf16(bfr[n], af, acc[n], 0, 0, 0);
    }
    bf16_t* yp = Yrow + 768 + GRP * 64 + 8 * fq;
#pragma unroll
    for (int k = 0; k < 2; ++k) { u32x4 w; w.x = cvt_pk_bf16(acc[2 * k][0], acc[2 * k][1]); w.y = cvt_pk_bf16(acc[2 * k][2], acc[2 * k][3]); w.z = cvt_pk_bf16(acc[2 * k + 1][0], acc[2 * k + 1][1]); w.w = cvt_pk_bf16(acc[2 * k + 1][2], acc[2 * k + 1][3]); *(u32x4*)(yp + 32 * k) = w; }
}
__device__ __forceinline__ void mixer_chunk(LAS unsigned char* lds, int chunk, unsigned char* __restrict__ ws,
                                            const bf16_t* __restrict__ sguw, const float* __restrict__ sgub, const float* __restrict__ lng, const float* __restrict__ lnb,
                                            const float* __restrict__ convw, const bf16_t* __restrict__ wpT) {
    int tid_ = threadIdx.x; asm volatile("" : "+v"(tid_));
    const int tid = tid_, wid = __builtin_amdgcn_readfirstlane(tid >> 6), lane = tid & 63, fr = lane & 15, fq = lane >> 4;
    const int T0 = chunk * 128;
    const bf16_t* __restrict__ Pc = prow(ws, T0);
    bf16_t* __restrict__ Yc = (bf16_t*)(ws + slice_off(T0) + SL_YCAT) + (size_t)(T0 & 4095) * D;
    {
        const int pr = tid >> 3, q = tid & 7;
        const bf16_t* src = Pc + (size_t)(2 * pr) * DINP + OFF_VA + 8 * q;
#pragma unroll 1
        for (int hb = 0; hb < 6; hb += 3) {
        u32x4 r0[3], r1[3];
#pragma unroll
        for (int hh = 0; hh < 3; ++hh) { r0[hh] = *(const u32x4*)(src + (hb + hh) * 64); r1[hh] = *(const u32x4*)(src + DINP + (hb + hh) * 64); }
#pragma unroll
        for (int hh = 0; hh < 3; ++hh) { const int h = hb + hh;
            LAS unsigned char* buf = lds + h * VNT_BYTES;
            float a[8], b[8]; unpack8(r0[hh], a); unpack8(r1[hh], b); gelu8(a); gelu8(b);
            float s0 = 0.f, s1 = 0.f;
#pragma unroll
            for (int j = 0; j < 8; ++j) { s0 += a[j]; s1 += b[j]; }
            s0 += __shfl_xor(s0, 1); s1 += __shfl_xor(s1, 1); s0 += __shfl_xor(s0, 2); s1 += __shfl_xor(s1, 2); s0 += __shfl_xor(s0, 4); s1 += __shfl_xor(s1, 4);
            const float m0 = s0 * (1.f / 64.f), m1 = s1 * (1.f / 64.f);
            float q0 = 0.f, q1 = 0.f;
#pragma unroll
            for (int j = 0; j < 8; ++j) { a[j] -= m0; b[j] -= m1; q0 += a[j] * a[j]; q1 += b[j] * b[j]; }
            q0 += __shfl_xor(q0, 1); q1 += __shfl_xor(q1, 1); q0 += __shfl_xor(q0, 2); q1 += __shfl_xor(q1, 2); q0 += __shfl_xor(q0, 4); q1 += __shfl_xor(q1, 4);
            const float rs0 = __builtin_amdgcn_rsqf(q0 * (1.f / 64.f) + LN_EPS), rs1 = __builtin_amdgcn_rsqf(q1 * (1.f / 64.f) + LN_EPS);
            const f32x4 g0 = *(const f32x4*)(lng + h * 64 + 8 * q), g1 = *(const f32x4*)(lng + h * 64 + 8 * q + 4);
            const f32x4 c0 = *(const f32x4*)(lnb + h * 64 + 8 * q), c1 = *(const f32x4*)(lnb + h * 64 + 8 * q + 4);
#pragma unroll
            for (int j = 0; j < 8; ++j) {
                const float gg = j < 4 ? g0[j & 3] : g1[j & 3], cc = j < 4 ? c0[j & 3] : c1[j & 3];
                const unsigned w = cvt_pk_bf16(a[j] * rs0 * gg + cc, b[j] * rs1 * gg + cc);
                *(LAS unsigned*)(buf + (8 * q + j) * VNT_STRIDE + pr * 4) = w;
            }
        }
        }
    }
    if (tid < 384) {
        const int strip = tid / 48, grp = tid % 48, ch = grp * 8;
        float w0[8], w1[8], w2[8], hm2[8], hm1[8];
        { const f32x4 a0 = *(const f32x4*)(convw + ch), a1 = *(const f32x4*)(convw + ch + 4), b0 = *(const f32x4*)(convw + 384 + ch), b1 = *(const f32x4*)(convw + 384 + ch + 4),
                      c0 = *(const f32x4*)(convw + 768 + ch), c1 = *(const f32x4*)(convw + 768 + ch + 4);
#pragma unroll
          for (int j = 0; j < 4; ++j) { w0[j] = a0[j]; w0[j + 4] = a1[j]; w1[j] = b0[j]; w1[j + 4] = b1[j]; w2[j] = c0[j]; w2[j + 4] = c1[j]; } }
        const int tg0 = T0 + strip * 16, tl0 = strip * 16;
        {
            const bool first = (tg0 & (SEQ - 1)) == 0;
            const bf16_t* pz = prow(ws, first ? tg0 : tg0 - 2) + ch;
            float z[8], c[8]; const float mk = first ? 0.f : 1.f;
            unpack8(*(const u32x4*)(pz + OFF_ZB), z); unpack8(*(const u32x4*)(pz + OFF_GC), c);
#pragma unroll
            for (int j = 0; j < 8; ++j) hm2[j] = mk * z[j] * c[j];
            unpack8(*(const u32x4*)(pz + DINP + OFF_ZB), z); unpack8(*(const u32x4*)(pz + DINP + OFF_GC), c);
#pragma unroll
            for (int j = 0; j < 8; ++j) hm1[j] = mk * z[j] * c[j];
        }
#pragma unroll 1
        for (int i0 = 0; i0 < 16; i0 += 4) {
            u32x4 rz[4], rc[4], rg[4];
#pragma unroll
            for (int k = 0; k < 4; ++k) { const bf16_t* pz = Pc + (size_t)(tl0 + i0 + k) * DINP + ch; rz[k] = *(const u32x4*)(pz + OFF_ZB); rc[k] = *(const u32x4*)(pz + OFF_GC); rg[k] = *(const u32x4*)(pz + OFF_GB); }
#pragma unroll
            for (int k = 0; k < 4; ++k) {
                float z[8], c[8], gbv[8], o[8];
                unpack8(rz[k], z); unpack8(rc[k], c); unpack8(rg[k], gbv);
#pragma unroll
                for (int j = 0; j < 8; ++j) { const float hh = z[j] * c[j]; o[j] = gbv[j] * (w0[j] * hm2[j] + w1[j] * hm1[j] + w2[j] * hh); hm2[j] = hm1[j]; hm1[j] = hh; }
                *(u32x4*)(Yc + (size_t)(tl0 + i0 + k) * D + 384 + ch) = pack8(o);
            }
        }
    }
    __syncthreads();
    {
        const int t0 = 16 * wid, nks = (wid >> 1) + 1, t = t0 + fr;
        const bf16_t* up = Pc + (size_t)t * DINP + OFF_UA + 8 * fq;
        bf16_t* yp = Yc + (size_t)t * D + 8 * fq;
#pragma unroll 2
        for (int h = 0; h < 6; ++h) {
            const LAS unsigned char* buf = lds + h * VNT_BYTES;
            u32x4 uu[2];
#pragma unroll
            for (int k = 0; k < 2; ++k) uu[k] = *(const u32x4*)(up + h * 64 + 32 * k);
            const float bs = sgub[h * 128 + t];
            f32x4 acc[4];
#pragma unroll
            for (int n = 0; n < 4; ++n) acc[n] = (f32x4){0.f, 0.f, 0.f, 0.f};
            const bf16_t* Wr = sguw + h * 16384 + (t0 + fr) * 128 + 8 * fq;
            for (int ks = 0; ks < nks; ++ks) {
                const bf16x8 af = *(const bf16x8*)(Wr + ks * 32);
#pragma unroll
                for (int n = 0; n < 4; ++n) {
                    const bf16x8 bfr = *(const LAS bf16x8*)(buf + (32 * (n >> 1) + 8 * (fr >> 2) + 4 * (n & 1) + (fr & 3)) * VNT_STRIDE + (ks * 32 + 8 * fq) * 2);
                    acc[n] = __builtin_amdgcn_mfma_f32_16x16x32_bf16(bfr, af, acc[n], 0, 0, 0);
                }
            }
#pragma unroll
            for (int k = 0; k < 2; ++k) {
                const f32x2 ga = gelu_pk((f32x2){bf_lo(uu[k].x), bf_hi(uu[k].x)}), gb = gelu_pk((f32x2){bf_lo(uu[k].y), bf_hi(uu[k].y)});
                const f32x2 gc = gelu_pk((f32x2){bf_lo(uu[k].z), bf_hi(uu[k].z)}), gd = gelu_pk((f32x2){bf_lo(uu[k].w), bf_hi(uu[k].w)});
                u32x4 w; w.x = cvt_pk_bf16(ga.x * (acc[2 * k][0] + bs), ga.y * (acc[2 * k][1] + bs)); w.y = cvt_pk_bf16(gb.x * (acc[2 * k][2] + bs), gb.y * (acc[2 * k][3] + bs));
                w.z = cvt_pk_bf16(gc.x * (acc[2 * k + 1][0] + bs), gc.y * (acc[2 * k + 1][1] + bs)); w.w = cvt_pk_bf16(gd.x * (acc[2 * k + 1][2] + bs), gd.y * (acc[2 * k + 1][3] + bs));
                *(u32x4*)(yp + h * 64 + 32 * k) = w;
            }
        }
    }
    {
        const int G = T0 + 16 * wid + fr, pos = G & (SEQ - 1);
        bf16_t* Yrow = Yc + (size_t)(16 * wid + fr) * D;
        pool_group<0>(ws, Yrow, wpT, G, pos, fr, fq); pool_group<1>(ws, Yrow, wpT, G, pos, fr, fq); pool_group<2>(ws, Yrow, wpT, G, pos, fr, fq); pool_group<3>(ws, Yrow, wpT, G, pos, fr, fq);
    }
    __syncthreads();
}

__device__ __forceinline__ float wave_sum(float v) {
#pragma unroll
    for (int o = 1; o < 64; o <<= 1) v += __shfl_xor(v, o);
    return v;
}
__device__ __forceinline__ void transpose_item(const float* __restrict__ W, const float* __restrict__ gain, int K, int N, bf16_t* __restrict__ WT, LAS float* scr, int item, int lane) {
    const int nblk = N / 32, kb = item / nblk, nb = item % nblk, k0 = 64 * kb, n0 = 32 * nb;
#pragma unroll
    for (int i = 0; i < 32; ++i) { const int kk = 2 * i + (lane >> 5); const float gsc = gain ? gain[k0 + kk] : 1.0f; scr[kk * 33 + (lane & 31)] = W[(size_t)(k0 + kk) * N + n0 + (lane & 31)] * gsc; }
    asm volatile("s_waitcnt lgkmcnt(0)" ::: "memory");
    const int c = lane & 7;
#pragma unroll
    for (int j = 0; j < 4; ++j) { const int n = (lane >> 3) + 8 * j; const LAS float* s = scr + (8 * c) * 33 + n;
        u32x4 o; o.x = cvt_pk_bf16(s[0 * 33], s[1 * 33]); o.y = cvt_pk_bf16(s[2 * 33], s[3 * 33]); o.z = cvt_pk_bf16(s[4 * 33], s[5 * 33]); o.w = cvt_pk_bf16(s[6 * 33], s[7 * 33]);
        *(u32x4*)(WT + (size_t)(n0 + n) * K + k0 + 8 * c) = o; }
    asm volatile("s_waitcnt lgkmcnt(0)" ::: "memory");
}


#define XB_TMO      128
#define XB_XCNT(j)  (256  + 64 * (j))
#define XB_XSUB(j)  (1280 + 64 * (j))
#define XB_XGEN(j)  (2304 + 64 * (j))
#define XB_TOP      3328
#define XB_TOPGEN   3392
#define XCD_BAR_WORDS 3456
#define XB_SPIN_CAP (1u << 22)
__device__ __forceinline__ unsigned xb_ld(unsigned* p)              { return __hip_atomic_load(p, __ATOMIC_RELAXED, __HIP_MEMORY_SCOPE_AGENT); }
__device__ __forceinline__ unsigned xb_add(unsigned* p, unsigned v) { return __hip_atomic_fetch_add(p, v, __ATOMIC_RELAXED, __HIP_MEMORY_SCOPE_AGENT); }
__device__ __forceinline__ unsigned xb_xcc_id() { return (unsigned)__builtin_amdgcn_s_getreg((3 << 11) | 20) & 0xFu; }
#define XB_SPIN(cond, bar) do { unsigned _sp = 0; while (cond) { __builtin_amdgcn_s_sleep(1); \
    if ((++_sp & 255u) == 0u) { if (xb_ld(&(bar)[XB_TMO])) break; if (_sp > XB_SPIN_CAP) { atomicAdd(&(bar)[XB_TMO], 1u); break; } } } } while (0)
struct XcdBarrier { unsigned* bar; unsigned x; volatile LAS unsigned* st; };
__device__ __forceinline__ XcdBarrier xcd_barrier_post(unsigned* bar, volatile LAS unsigned* st) {
    XcdBarrier b; b.bar = bar; b.x = xb_xcc_id(); b.st = st;
    if (threadIdx.x == 0) st[2] = xb_add(&bar[XB_XCNT(b.x)], 1u);
    return b;
}
__device__ __forceinline__ void xcd_barrier_complete(unsigned* bar, unsigned x, unsigned& nloc, unsigned& nx) {
    const unsigned G = gridDim.x * gridDim.y * gridDim.z;
    unsigned sum, cnt, mine, sp = 0u;
    for (;;) {
        sum = 0u; cnt = 0u; mine = 0u;
#pragma unroll
        for (unsigned j = 0; j < 16; ++j) { const unsigned c = xb_ld(&bar[XB_XCNT(j)]); sum += c; cnt += (c > 0u) ? 1u : 0u; mine = (j == x) ? c : mine; }
        if (sum == G) break;
        __builtin_amdgcn_s_sleep(1);
        if ((++sp & 255u) == 0u) { if (xb_ld(&bar[XB_TMO])) break; if (sp > XB_SPIN_CAP) { atomicAdd(&bar[XB_TMO], 1u); break; } }
    }
    nloc = mine > 0u ? mine : 1u; nx = cnt > 0u ? cnt : 1u;
}
__device__ __forceinline__ void xcd_barrier(const XcdBarrier& b, bool local = false) {
    asm volatile("s_waitcnt vmcnt(0)" ::: "memory");
    __syncthreads();
    if (threadIdx.x == 0) {
        unsigned* bar = b.bar;
        __builtin_amdgcn_s_waitcnt(0);
        unsigned nloc = b.st[0], nx = b.st[1];
        if (nloc == 0u) { xcd_barrier_complete(bar, b.x, nloc, nx); b.st[0] = nloc; b.st[1] = nx; }
        const unsigned old = xb_add(&bar[XB_XSUB(b.x)], 1u);
        const unsigned gen = old / nloc;
        if (local) {
            if (old + 1u == (gen + 1u) * nloc) xb_add(&bar[XB_XGEN(b.x)], 1u);
            else XB_SPIN(xb_ld(&bar[XB_XGEN(b.x)]) == gen, bar);
            __builtin_amdgcn_fence(__ATOMIC_ACQUIRE, "agent");
            asm volatile("s_waitcnt vmcnt(0)" ::: "memory");
        } else if (old + 1u == (gen + 1u) * nloc) {
            __builtin_amdgcn_fence(__ATOMIC_RELEASE, "agent");
            asm volatile("s_waitcnt vmcnt(0)" ::: "memory");
            const unsigned og = xb_add(&bar[XB_TOP], 1u);
            const unsigned tg = og / nx;
            if (og + 1u == (tg + 1u) * nx) xb_add(&bar[XB_TOPGEN], 1u);
            else XB_SPIN(xb_ld(&bar[XB_TOPGEN]) == tg, bar);
            __builtin_amdgcn_fence(__ATOMIC_ACQUIRE, "agent");
            xb_add(&bar[XB_XGEN(b.x)], 1u);
            asm volatile("s_waitcnt vmcnt(0)" ::: "memory");
        } else {
            XB_SPIN(xb_ld(&bar[XB_XGEN(b.x)]) == gen, bar);
            __builtin_amdgcn_fence(__ATOMIC_ACQUIRE, "agent");
            asm volatile("s_waitcnt vmcnt(0)" ::: "memory");
        }
    }
    __syncthreads();
}

struct Args { const float* in[19]; float* out; unsigned char* ws; };

__device__ __forceinline__ void prologue(const Args& a, LAS unsigned char* lds) {
    const int tid = threadIdx.x, wave = __builtin_amdgcn_readfirstlane(tid >> 6), lane = tid & 63;
    const int G = gridDim.x, gw = blockIdx.x * 8 + wave, NGW = G * 8;
    const size_t gt = (size_t)blockIdx.x * 512 + tid, NT = (size_t)G * 512;
    unsigned char* ws = a.ws;
    LAS float* scr = (LAS float*)(lds + wave * 16384);
    constexpr int I_IN = 16 * (DIN / 32), I_OUT = 16 * 32, I_FF1 = 16 * (FF / 32), I_FF2 = 64 * 32, I_G = 16 * 32, I_P = 4 * 32, I_L = I_IN + I_OUT + I_FF1 + I_FF2 + I_G + I_P;
    for (int it = gw; it < DEPTH * I_L; it += NGW) {
        const int l = it / I_L; int r = it % I_L; unsigned char* wl = ws + WS_W + (size_t)l * LW;
        if (r < I_IN) { transpose_item(a.in[3] + (size_t)l * D * DIN, a.in[2] + l * D, D, DIN, (bf16_t*)(wl + LW_IN), scr, r, lane); continue; } r -= I_IN;
        if (r < I_OUT) { transpose_item(a.in[11] + (size_t)l * D * D, nullptr, D, D, (bf16_t*)(wl + LW_OUT), scr, r, lane); continue; } r -= I_OUT;
        if (r < I_FF1) { transpose_item(a.in[13] + (size_t)l * D * FF, a.in[12] + l * D, D, FF, (bf16_t*)(wl + LW_FF1), scr, r, lane); continue; } r -= I_FF1;
        if (r < I_FF2) { transpose_item(a.in[14] + (size_t)l * FF * D, nullptr, FF, D, (bf16_t*)(wl + LW_FF2), scr, r, lane); continue; } r -= I_FF2;
        if (r < I_G) { transpose_item(a.in[16] + (size_t)l * D * D, a.in[15] + l * D, D, D, (bf16_t*)(wl + LW_G), scr, r, lane); continue; } r -= I_G;
        transpose_item(a.in[17] + (size_t)l * DPLE * D, nullptr, DPLE, D, (bf16_t*)(wl + LW_P), scr, r, lane);
    }
    for (size_t i = gt; i < (size_t)DEPTH * 16384; i += NT) { const int l = (int)(i >> 14); const size_t j = i & 16383;
        *(u32x4*)(ws + WS_W + (size_t)l * LW + LW_IN + (size_t)DIN * D * 2 + j * 16) = (u32x4){0u, 0u, 0u, 0u}; }
    for (size_t i = gt; i < (size_t)DEPTH * 6 * 16384; i += NT) { const int l = (int)(i / (6 * 16384)); const int r = (int)(i % (6 * 16384)); const int t = (r >> 7) & 127, s = r & 127;
        const float v = s <= t ? a.in[4][i] : 0.f; ((bf16_t*)(ws + WS_W + (size_t)l * LW + LW_SGU))[r] = (bf16_t)(cvt_pk_bf16(v, 0.f) & 0xffffu); }
    for (size_t i = gt; i < (size_t)DEPTH * 16384; i += NT) { const int l = (int)(i >> 14), r = (int)(i & 16383), g = r >> 12, d = (r >> 6) & 63, c = r & 63;
        const float v = a.in[9][(size_t)l * 16384 + g * 4096 + c * 64 + d] * a.in[10][l * 256 + g * 64 + d];
        ((bf16_t*)(ws + WS_W + (size_t)l * LW + LW_POOL))[r] = (bf16_t)(cvt_pk_bf16(v, 0.f) & 0xffffu); }
    for (size_t i = gt; i < 4 * 768; i += NT) ((float*)(ws + WS_SM_SGUB))[i] = a.in[5][i];
    for (size_t i = gt; i < 4 * 384; i += NT) { ((float*)(ws + WS_SM_LNG))[i] = a.in[6][i]; ((float*)(ws + WS_SM_LNB))[i] = a.in[7][i]; }
    for (size_t i = gt; i < 4 * 1152; i += NT) ((float*)(ws + WS_SM_CONV))[i] = a.in[8][i];
    for (size_t i = gt; i < 1024; i += NT) ((float*)(ws + WS_SM_FG))[i] = a.in[18][i];
    { const f32x4* src = (const f32x4*)a.in[1]; u32x4* dst = (u32x4*)(ws + WS_PB);
      constexpr size_t NIT = (size_t)DEPTH * M * DPLE / 8;
      for (size_t i = gt; i < NIT; i += 4 * NT) { f32x4 v0[4], v1[4];
#pragma unroll
          for (int k = 0; k < 4; ++k) { const size_t ii = i + k * NT < NIT ? i + k * NT : i; v0[k] = src[2 * ii]; v1[k] = src[2 * ii + 1]; }
#pragma unroll
          for (int k = 0; k < 4; ++k) { if (i + k * NT < NIT) { u32x4 w; w.x = cvt_pk_bf16(v0[k][0], v0[k][1]); w.y = cvt_pk_bf16(v0[k][2], v0[k][3]); w.z = cvt_pk_bf16(v1[k][0], v1[k][1]); w.w = cvt_pk_bf16(v1[k][2], v1[k][3]); dst[i + k * NT] = w; } } } }
    { bf16_t* xb = (bf16_t*)(ws + WS_XB); float* ssqp = (float*)(ws + WS_SSQ);
      for (int m0 = gw; m0 < M; m0 += 2 * NGW) {
          f32x4 v[2][4];
#pragma unroll
          for (int r = 0; r < 2; ++r) { const f32x4* xr = (const f32x4*)(a.in[0] + (size_t)(m0 + r * NGW) * D) + lane;
#pragma unroll
              for (int j = 0; j < 4; ++j) v[r][j] = xr[64 * j]; }
#pragma unroll
          for (int r = 0; r < 2; ++r) { const int m = m0 + r * NGW; float s = 0.f; u32x2* o8 = (u32x2*)(xb + (size_t)m * D) + lane;
#pragma unroll
              for (int j = 0; j < 4; ++j) { const f32x4 q = v[r][j]; s += (q[0] * q[0] + q[1] * q[1]) + (q[2] * q[2] + q[3] * q[3]); u32x2 w; w.x = cvt_pk_bf16(q[0], q[1]); w.y = cvt_pk_bf16(q[2], q[3]); o8[64 * j] = w; }
              s = wave_sum(s);
              if (lane < 16) ssqp[(size_t)m * 16 + lane] = lane == 0 ? s : 0.f; } } }
}

__device__ __forceinline__ void final_norm(const Args& a, bool fast, int cid) {
    int tid_ = threadIdx.x; asm volatile("" : "+v"(tid_));
    const int tid = tid_, wave = __builtin_amdgcn_readfirstlane(tid >> 6), lane = tid & 63;
    const int per = M / (int)gridDim.x, NGW = fast ? 8 : (int)gridDim.x * 8, gw = fast ? wave : (int)blockIdx.x * 8 + wave;
    const int mbase = fast ? ((cid & 7) * ((int)gridDim.x / 8) + (cid >> 3)) * per : 0, mend = fast ? mbase + per : M;
    const float* ssqp = (const float*)(a.ws + WS_SSQ); const bf16_t* xb = (const bf16_t*)(a.ws + WS_XB);
    f32x4 gv[2][2];
#pragma unroll
    for (int j = 0; j < 2; ++j) { gv[j][0] = ((const f32x4*)(a.ws + WS_SM_FG))[2 * (lane + 64 * j)]; gv[j][1] = ((const f32x4*)(a.ws + WS_SM_FG))[2 * (lane + 64 * j) + 1]; }
    for (int m = mbase + gw; m < mend; m += NGW) {
        const f32x4* sp = (const f32x4*)(ssqp + (size_t)m * 16);
        const f32x4 s4 = (sp[0] + sp[1]) + (sp[2] + sp[3]);
        const float rs = __builtin_amdgcn_rsqf(((s4[0] + s4[1]) + (s4[2] + s4[3])) * (1.0f / D) + RMS_EPS);
        const u32x4* xr = (const u32x4*)(xb + (size_t)m * D); f32x4* orow = (f32x4*)(a.out + (size_t)m * D);
#pragma unroll
        for (int j = 0; j < 2; ++j) { const u32x4 v = xr[lane + 64 * j];
            orow[2 * (lane + 64 * j)] = (f32x4){bf_lo(v.x), bf_hi(v.x), bf_lo(v.y), bf_hi(v.y)} * rs * gv[j][0];
            orow[2 * (lane + 64 * j) + 1] = (f32x4){bf_lo(v.z), bf_hi(v.z), bf_lo(v.w), bf_hi(v.w)} * rs * gv[j][1]; }
    }
}

__global__ void __launch_bounds__(512, 2) fwd_megakernel(Args a) {
    extern __shared__ __attribute__((aligned(16))) unsigned char lds_raw[];
    LAS unsigned char* lds = (LAS unsigned char*)lds_raw;
    cg::grid_group grid = cg::this_grid();
    const int G = gridDim.x;
#define BARRIER(local_) do { XcdBarrier b_; { size_t z_ = 0; asm volatile("" : "+s"(z_)); b_.bar = (unsigned*)(a.ws + z_) + 4096; } b_.x = xb_xcc_id(); b_.st = (volatile LAS unsigned*)(lds + 131072 + 320) + 8; xcd_barrier(b_, (local_)); } while (0)
#define GRID_SYNC() BARRIER(false)
#define XCD_SYNC() BARRIER(fast)
#define PTRS() size_t z_ = 0; asm volatile("" : "+s"(z_)); unsigned char* ws = a.ws + z_;     \
    int l = l_; asm volatile("" : "+s"(l)); unsigned char* wl = ws + WS_W + (size_t)l * LW; \
    bf16_t* xb = (bf16_t*)(ws + WS_XB); float* sq = (float*)(ws + WS_SSQ); (void)wl; (void)xb; (void)sq;

#ifndef PH
#define PH 0xffff
#endif
    volatile LAS unsigned* MISC = (volatile LAS unsigned*)(lds + 131072 + 320);
    if (threadIdx.x < 32) MISC[threadIdx.x] = 0u;
    __syncthreads();
    if (blockIdx.x == 0) for (int i = threadIdx.x; i < XCD_BAR_WORDS; i += 512) __hip_atomic_store((unsigned*)(a.ws) + 4096 + i, 0u, __ATOMIC_RELAXED, __HIP_MEMORY_SCOPE_AGENT);
    if (blockIdx.x == 0) for (int i = threadIdx.x; i < 128 * 64; i += 512) __hip_atomic_store((unsigned*)(a.ws + WS_PANEL) + i, 0u, __ATOMIC_RELAXED, __HIP_MEMORY_SCOPE_AGENT);
    asm volatile("s_waitcnt vmcnt(0)" ::: "memory");
    grid.sync();
    asm volatile("s_waitcnt vmcnt(0)" ::: "memory");
    (void)xcd_barrier_post((unsigned*)(a.ws) + 4096, MISC + 8);
#if PH & 1
    prologue(a, lds);
#endif
    GRID_SYNC();
    bool fast; int cid;
    {
        unsigned* bar = (unsigned*)(a.ws) + 4096; bool ok = (G % 8 == 0) && (G / 8) * 8 == G;
#pragma unroll
        for (int j = 0; j < 16; ++j) { const unsigned cj = xb_ld(&bar[XB_XCNT(j)]); ok = ok && (cj == (j < 8 ? (unsigned)(G / 8) : 0u)); }
        __syncthreads();
        const int xcc = (int)xb_xcc_id(), rank = (int)MISC[10];
        fast = __builtin_amdgcn_readfirstlane(ok ? 1 : 0) != 0;
        cid = __builtin_amdgcn_readfirstlane(fast ? 8 * rank + xcc : (int)blockIdx.x);
    }

#pragma unroll 1
    for (int l_ = 0; l_ < DEPTH; ++l_) {
#if PH & 2
        {
            PTRS();
            pg8::Gemm g{xb, (const bf16_t*)(wl + LW_IN), M, DINP, D, (size_t)16 * 256 * D * 2}; pg8::StaticOrder S; S.init(M, DINP, G, cid);
            pg8::EpiProj<0> E{(bf16_t*)(ws + WS_R1 + SL_PROJ), DINP};
            pg8::gemm_phase<pg8::EpiProj<0>, pg8::StaticOrder, true, true, pg8::RsPre>(lds, g, S, E, pg8::RsPre{sq});
        }
#endif
        GRID_SYNC();
#if PH & 4
        { PTRS();
          const int nch = M / 128;
          for (int c = fast ? (cid & 7) * (nch / 8) + (cid >> 3) : cid; c < nch; c += fast ? nch : G)
            mixer_chunk(lds, c, ws, (const bf16_t*)(wl + LW_SGU), (const float*)(ws + WS_SM_SGUB) + l * 768, (const float*)(ws + WS_SM_LNG) + l * 384, (const float*)(ws + WS_SM_LNB) + l * 384, (const float*)(ws + WS_SM_CONV) + l * 1152, (const bf16_t*)(wl + LW_POOL)); }
#endif
        GRID_SYNC();
#if PH & 8
        {
            PTRS();
            pg8::Gemm g{(const bf16_t*)(ws + WS_R1 + SL_YCAT), (const bf16_t*)(wl + LW_OUT), M, D, D, XS}; pg8::StaticOrder S; S.init(M, D, G, cid);
            pg8::EpiRes<false> E{xb, xb, sq, nullptr, 0u};
            pg8::gemm_phase<pg8::EpiRes<false>, pg8::StaticOrder, true, true>(lds, g, S, E);
        }
#endif
        XCD_SYNC();
#if PH & 16
        {
            PTRS();
            pg8::Gemm g{xb, (const bf16_t*)(wl + LW_FF1), M, FF, D, (size_t)16 * 256 * D * 2}; pg8::StaticOrder S; S.init(M, FF, G, cid);
            pg8::EpiProj<1> E{(bf16_t*)(ws + WS_R1 + SL_HID), FF};
            pg8::gemm_phase<pg8::EpiProj<1>, pg8::StaticOrder, true, true, pg8::RsPre>(lds, g, S, E, pg8::RsPre{sq});
        }
#endif
        XCD_SYNC();
#if PH & 32
        {
            PTRS();
            pg8::Gemm g{(const bf16_t*)(ws + WS_R1 + SL_HID), (const bf16_t*)(wl + LW_FF2), M, D, FF, XS}; pg8::StaticOrder S; S.init(M, D, G, cid);
            pg8::EpiRes<false> E{xb, xb, sq, nullptr, 0u};
            pg8::gemm_phase<pg8::EpiRes<false>, pg8::StaticOrder, true, true>(lds, g, S, E);
        }
#endif
        XCD_SYNC();
#if PH & 64
        {
            PTRS();
            pg8::StaticOrder S; S.init(M, D, G, cid);
            { pg8::Gemm g2{(const bf16_t*)(ws + WS_PB) + (size_t)l * M * DPLE, (const bf16_t*)(wl + LW_P), M, D, DPLE, (size_t)16 * 256 * DPLE * 2};
              pg8::EpiPle E2{ws};
              pg8::gemm_phase<pg8::EpiPle, pg8::StaticOrder, true, true>(lds, g2, S, E2); }
            pg8::Gemm g{xb, (const bf16_t*)(wl + LW_G), M, D, D, (size_t)16 * 256 * D * 2};
            pg8::EpiRes<true> E{xb, xb, sq, ws, 4u * (unsigned)(l + 1)};
            pg8::gemm_phase<pg8::EpiRes<true>, pg8::StaticOrder, true, true, pg8::RsPre>(lds, g, S, E, pg8::RsPre{sq});
        }
#endif
        XCD_SYNC();
    }
#if PH & 256
    final_norm(a, fast, cid);
#endif
}

extern "C" void kernel_launch(void* const* d_in, const int* in_sizes, int n_in, void* d_out, int out_size, void* d_ws, size_t ws_size, hipStream_t stream) {
    static int grid_blocks = 0;
    if (grid_blocks == 0) {
        if (n_in != 19 || out_size != M * D || ws_size < WS_END) { fprintf(stderr, "kernel_launch: unexpected shapes (n_in %d out %d ws %zu, need %zu)\n", n_in, out_size, ws_size, (size_t)WS_END); grid_blocks = -1; return; }
        int dev = 0, cus = 0, per_cu = 0;
        hipGetDevice(&dev);
        hipDeviceGetAttribute(&cus, hipDeviceAttributeMultiprocessorCount, dev);
        if (hipFuncSetAttribute((const void*)fwd_megakernel, hipFuncAttributeMaxDynamicSharedMemorySize, LDS_BYTES) != hipSuccess) { fprintf(stderr, "kernel_launch: hipFuncSetAttribute failed\n"); grid_blocks = -1; return; }
        if (hipOccupancyMaxActiveBlocksPerMultiprocessor(&per_cu, (const void*)fwd_megakernel, 512, LDS_BYTES) != hipSuccess || per_cu < 1) { fprintf(stderr, "kernel_launch: occupancy query gave %d\n", per_cu); per_cu = 1; }
        (void)hipGetLastError();
        grid_blocks = cus * 1;
    }
    if (grid_blocks < 0) return;
    Args a{};
    for (int i = 0; i < 19; ++i) a.in[i] = (const float*)d_in[i];
    a.out = (float*)d_out; a.ws = (unsigned char*)d_ws;
    void* args[] = {&a};
    hipError_t e = hipLaunchCooperativeKernel((const void*)fwd_megakernel, dim3(grid_blocks), dim3(512), args, LDS_BYTES, stream);
    if (e != hipSuccess) fprintf(stderr, "cooperative launch failed: %s (grid %d)\n", hipGetErrorString(e), grid_blocks);
}
```

```cpp
#include <hip/hip_runtime.h>
#include <hip/hip_cooperative_groups.h>
#include <cstdio>
#include <cstdint>
namespace cg = cooperative_groups;

#define LAS __attribute__((address_space(3)))
typedef unsigned short bf16_t;
typedef short bf16x8 __attribute__((ext_vector_type(8)));
typedef float f32x4 __attribute__((ext_vector_type(4)));
typedef float f32x2 __attribute__((ext_vector_type(2)));
typedef unsigned u32x4 __attribute__((ext_vector_type(4)));
typedef unsigned u32x2 __attribute__((ext_vector_type(2)));

constexpr int M = 32768, SEQ = 16384, D = 1024, DIN = 2176, DINP = 2304, FF = 4096, DPLE = 256, DEPTH = 4;
constexpr int PLD = 1792, OFF_UA = 0, OFF_VA = 384, OFF_GB = 768, OFF_ZC0 = 1152, OFF_H = 1280, OFF_ZC1 = 1664;
__host__ __device__ __forceinline__ int inproj_row(int n) {
    if (n < 768) return n;
    if (n < 1152) { const int j = n - 768; return 1280 + 256 * (j >> 7) + (j & 127); }
    if (n < 1536) return 768 + (n - 1152);
    if (n < 1920) { const int j = n - 1536; return 1280 + 256 * (j >> 7) + 128 + (j & 127); }
    { const int j = n - 1920; return j < 128 ? 1152 + j : 2048 + (j - 128); }
}
constexpr float RMS_EPS = 1e-6f, LN_EPS = 1e-5f;

constexpr size_t MiB = 1u << 20, KiB = 1u << 10;
constexpr size_t WS_W = 1 * MiB, LW = 26 * MiB;
constexpr size_t LW_IN = 0, LW_OUT = 4608 * KiB, LW_FF1 = LW_OUT + 2 * MiB, LW_FF2 = LW_FF1 + 8 * MiB, LW_G = LW_FF2 + 8 * MiB, LW_P = LW_G + 2 * MiB,
                 LW_SGU = LW_P + 512 * KiB, LW_POOL = LW_SGU + 192 * KiB;
static_assert(LW_POOL + 32 * KiB <= LW, "layer weights");
constexpr size_t WS_XB = WS_W + 4 * LW;
constexpr size_t WS_PB = WS_XB + 64 * MiB;
constexpr size_t WS_SSQ = WS_PB + 64 * MiB;
constexpr size_t WS_R1 = WS_SSQ + 2 * MiB;
constexpr size_t XS = 32 * MiB, SL_PROJ = 0, SL_YCAT = 18 * MiB, SL_HID = 0, SL_GATE = 0;
__device__ __forceinline__ size_t slice_off(int row) { return WS_R1 + (size_t)(row >> 12) * XS; }
constexpr size_t WS_END = WS_R1 + 256 * MiB;

constexpr size_t WS_SM_SGUB = 128 * KiB, WS_SM_LNG = 144 * KiB, WS_SM_LNB = 160 * KiB, WS_SM_CONV = 176 * KiB, WS_SM_FG = 208 * KiB;
constexpr int LDS_BYTES = 147456;

typedef __bf16 bf16x2_t __attribute__((ext_vector_type(2)));
__device__ __forceinline__ unsigned cvt_pk_bf16(float lo, float hi) { const f32x2 v = {lo, hi}; return __builtin_bit_cast(unsigned, __builtin_convertvector(v, bf16x2_t)); }
__device__ __forceinline__ float bf_lo(unsigned w) { return __uint_as_float(w << 16); }
__device__ __forceinline__ float bf_hi(unsigned w) { return __uint_as_float(w & 0xffff0000u); }
__device__ __forceinline__ f32x2 gelu_pk(f32x2 v) {
    const f32x2 av = __builtin_elementwise_abs(v), d = av * 0.2316418882f + 1.0f;
    f32x2 t; t.x = __builtin_amdgcn_rcpf(d.x); t.y = __builtin_amdgcn_rcpf(d.y);
    f32x2 q = t * 0.5307027145f + (-0.7265760135f); q = q * t + 0.7107068705f; q = q * t + (-0.142248368f); q = q * t + 0.127414796f; q = q * t;
    const f32x2 s = (v * v) * (-0.72134752044f);
    f32x2 e; e.x = __builtin_amdgcn_exp2f(s.x); e.y = __builtin_amdgcn_exp2f(s.y);
    const f32x2 m = v * (q * e), r = v - m;
    f32x2 o; o.x = v.x < 0.f ? m.x : r.x; o.y = v.y < 0.f ? m.y : r.y; return o;
}

namespace pg8 {
constexpr int BM = 256, BK = 64, HALF = 128, HTB = HALF * BK * 2, STAGE_BYTES = 8 * HTB, NXCD = 8, WGM = 8;
__host__ __device__ __forceinline__ int lds_byte(int r, int c) { const int st = (r >> 4) * 2 + (c >> 5), rr = r & 15, cc = c & 31, ob = rr * 64 + cc * 2; return st * 1024 + (ob ^ (((ob >> 9) & 1) << 5)); }
__host__ __device__ __forceinline__ void stage_rc(int b, int& R, int& C) { const int st = b / 1024, sb = b % 1024, swz = sb ^ (((sb >> 9) & 1) << 5); R = (st >> 1) * 16 + swz / 64; C = (st & 1) * 32 + (swz % 64) / 2; }
__host__ __device__ __forceinline__ int perm32(int rho) { const int n = rho >> 4, i = rho & 15; return 8 * (i >> 2) + 4 * n + (i & 3); }

struct Unit { int pm, pn; };
struct Gemm { const bf16_t* A; const bf16_t* Bt; int M, N, K; size_t axs; };

struct StaticOrder {
    int nM, nN, nwg, G, c;
    __host__ __device__ void init(int M_, int N_, int G_, int c_) { nM = M_ / BM; nN = N_ / BM; nwg = nM * nN; G = G_; c = c_; }
    __host__ __device__ bool next(int i, Unit& u) const {
        const long L = (long)i * G + c; if (L >= nwg) return false;
        int wgid = (int)L; { const int q = nwg / NXCD, r = nwg % NXCD, xcd = wgid % NXCD, off = wgid / NXCD; wgid = (xcd < r ? xcd * (q + 1) : r * (q + 1) + (xcd - r) * q) + off; }
        const int nig = WGM * nN, gid = wgid / nig, fm = gid * WGM, gsz = (nM - fm) < WGM ? (nM - fm) : WGM;
        u.pm = fm + ((wgid % nig) % gsz); u.pn = (wgid % nig) / gsz; return true;
    }
    __device__ __forceinline__ void a_ready(const Unit&) const {}
    __device__ __forceinline__ void done(const Unit&) const {}
};

constexpr int RSL_OFF = 131072 + 1024;
template <class Sched, bool SYNC = true> __device__ __forceinline__ void fill_rs(LAS unsigned char* lds, const Sched& S, const unsigned char* ws) {
    int tid_ = threadIdx.x; asm volatile("" : "+v"(tid_));
    const float* ssqp = (const float*)(ws + WS_SSQ); LAS float* rsl = (LAS float*)(lds + RSL_OFF);
    const int half = tid_ >> 8, r = tid_ & 255;
    Unit u;
    for (int i = half; S.next(i, u); i += 2) {
        const f32x4* sp = (const f32x4*)(ssqp + (unsigned)(u.pm * BM + r) * 16);
        const f32x4 s4 = (sp[0] + sp[1]) + (sp[2] + sp[3]);
        rsl[i * 256 + r] = __builtin_amdgcn_rsqf(((s4[0] + s4[1]) + (s4[2] + s4[3])) * (1.0f / D) + RMS_EPS);
    }
    if (SYNC) __syncthreads();
}
struct NoPre { template <class Sched> __device__ __forceinline__ void operator()(LAS unsigned char*, const Sched&) const {} };
struct RsPre { const unsigned char* ws; template <class Sched> __device__ __forceinline__ void operator()(LAS unsigned char* lds, const Sched& S) const { fill_rs<Sched, false>(lds, S, ws); } };
template <int N> __device__ __forceinline__ void wait_vm() { asm volatile("s_waitcnt vmcnt(%0)" :: "n"(N) : "memory"); }
template <int ACT> struct EpiProj {
    static constexpr bool PERM = true, AFTER_DRAIN = false; static constexpr int NST = 16;
    bf16_t* O; int ldc;
    __device__ __forceinline__ void operator()(const f32x4 (&acc)[2][2][4][2], const Unit& u, int ui, LAS unsigned char* lds, int wr, int wc, int fr, int fq) const {
        const LAS float* rsl = (const LAS float*)(lds + RSL_OFF) + ui * 256 + wr * 64 + fr;
        const int row0 = (u.pm & 15) * BM + wr * 64 + fr, col0 = u.pn * BM + wc * 32 + 8 * fq; bf16_t* Os = O + (size_t)(u.pm >> 4) * (XS / 2);
#pragma unroll
        for (int ai = 0; ai < 2; ++ai)
#pragma unroll
            for (int m = 0; m < 4; ++m) {
                const int row = row0 + ai * HALF + m * 16; const float rs = rsl[ai * HALF + m * 16];
                bf16_t* rowp = Os + (size_t)row * ldc + col0;
                if (ACT == 0 && u.pn >= 5) {
                    const int cw = wc * 32 + 8 * fq; f32x4 v0, v1;
                    if (u.pn < 8) { const float r2 = rs * rs; v0 = acc[ai][0][m][0] * acc[ai][1][m][0] * r2; v1 = acc[ai][0][m][1] * acc[ai][1][m][1] * r2; }
                    else { v0 = acc[ai][0][m][0] * rs; v1 = acc[ai][0][m][1] * rs; }
                    u32x4 w; w.x = cvt_pk_bf16(v0[0], v0[1]); w.y = cvt_pk_bf16(v0[2], v0[3]); w.z = cvt_pk_bf16(v1[0], v1[1]); w.w = cvt_pk_bf16(v1[2], v1[3]);
                    *(u32x4*)(Os + (size_t)row * ldc + (u.pn < 8 ? OFF_H + 128 * (u.pn - 5) : OFF_ZC1) + cw) = w;
                    continue;
                }
#pragma unroll
                for (int bj = 0; bj < 2; ++bj) {
                    f32x4 v0 = acc[ai][bj][m][0] * rs, v1 = acc[ai][bj][m][1] * rs;
                    if (ACT == 1) {
#pragma unroll
                        for (int j = 0; j < 4; ++j) { const float a = fmaxf(v0[j], 0.f), b = fmaxf(v1[j], 0.f); v0[j] = a * a; v1[j] = b * b; }
                    }
                    u32x4 w; w.x = cvt_pk_bf16(v0[0], v0[1]); w.y = cvt_pk_bf16(v0[2], v0[3]); w.z = cvt_pk_bf16(v1[0], v1[1]); w.w = cvt_pk_bf16(v1[2], v1[3]);
                    *(u32x4*)(rowp + bj * HALF) = w;
                }
            }
    }
};
struct EpiGate {
    static constexpr bool PERM = true, AFTER_DRAIN = false; static constexpr int NST = 16;
    unsigned char* ws;
    __device__ __forceinline__ void operator()(const f32x4 (&acc)[2][2][4][2], const Unit& u, int ui, LAS unsigned char* lds, int wr, int wc, int fr, int fq) const {
        const LAS float* rsl = (const LAS float*)(lds + RSL_OFF) + ui * 256 + wr * 64 + fr; bf16_t* gate = (bf16_t*)(ws + WS_R1 + (size_t)(u.pm >> 4) * XS + SL_GATE);
        const int row0 = (u.pm & 15) * BM + wr * 64 + fr, col0 = u.pn * BM + wc * 32 + 8 * fq;
#pragma unroll
        for (int ai = 0; ai < 2; ++ai)
#pragma unroll
            for (int m = 0; m < 4; ++m) {
                const unsigned off = (unsigned)(row0 + ai * HALF + m * 16) * D + col0; const float rs = rsl[ai * HALF + m * 16];
#pragma unroll
                for (int bj = 0; bj < 2; ++bj) {
                    f32x4 v0 = acc[ai][bj][m][0] * rs, v1 = acc[ai][bj][m][1] * rs;
#pragma unroll
                    for (int j = 0; j < 4; ++j) { v0[j] = __builtin_amdgcn_rcpf(1.0f + __builtin_amdgcn_exp2f(-1.44269504089f * v0[j])); v1[j] = __builtin_amdgcn_rcpf(1.0f + __builtin_amdgcn_exp2f(-1.44269504089f * v1[j])); }
                    u32x4 w; w.x = cvt_pk_bf16(v0[0], v0[1]); w.y = cvt_pk_bf16(v0[2], v0[3]); w.z = cvt_pk_bf16(v1[0], v1[1]); w.w = cvt_pk_bf16(v1[2], v1[3]);
                    *(u32x4*)(gate + off + bj * HALF) = w;
                }
            }
    }
};
template <bool GATED> struct EpiRes {
    static constexpr bool PERM = true, AFTER_DRAIN = false; static constexpr int NST = 24;
    unsigned char* ws;
    __device__ __forceinline__ void operator()(const f32x4 (&acc)[2][2][4][2], const Unit& u, int ui, LAS unsigned char* lds, int wr, int wc, int fr, int fq) const {
        bf16_t* xb = (bf16_t*)(ws + WS_XB); float* ssqp = (float*)(ws + WS_SSQ); const bf16_t* gate = (const bf16_t*)(ws + WS_R1 + (size_t)(u.pm >> 4) * XS + SL_GATE) - (size_t)(u.pm >> 4) * 4096 * D;
        const int row0 = u.pm * BM + wr * 64 + fr, col0 = u.pn * BM + wc * 32 + 8 * fq;
#pragma unroll
        for (int ai = 0; ai < 2; ++ai) {
            u32x4 b[4][2], g[4][2];
#pragma unroll
            for (int m = 0; m < 4; ++m) { const unsigned off = (unsigned)(row0 + ai * HALF + m * 16) * D + col0;
#pragma unroll
                for (int bj = 0; bj < 2; ++bj) { const unsigned c = off + bj * HALF; b[m][bj] = *(const u32x4*)(xb + c); if (GATED) g[m][bj] = *(const u32x4*)(gate + c); } }
#pragma unroll
            for (int m = 0; m < 4; ++m) { const int row = row0 + ai * HALF + m * 16; const unsigned off = (unsigned)row * D + col0; float q = 0.f;
#pragma unroll
                for (int bj = 0; bj < 2; ++bj) { const unsigned c = off + bj * HALF; f32x4 a0 = acc[ai][bj][m][0], a1 = acc[ai][bj][m][1];
                    if (GATED) { const u32x4 gg = g[m][bj]; a0[0] *= bf_lo(gg.x); a0[1] *= bf_hi(gg.x); a0[2] *= bf_lo(gg.y); a0[3] *= bf_hi(gg.y); a1[0] *= bf_lo(gg.z); a1[1] *= bf_hi(gg.z); a1[2] *= bf_lo(gg.w); a1[3] *= bf_hi(gg.w); }
                    const u32x4 bb = b[m][bj];
                    const f32x4 o0 = (f32x4){bf_lo(bb.x), bf_hi(bb.x), bf_lo(bb.y), bf_hi(bb.y)} + a0, o1 = (f32x4){bf_lo(bb.z), bf_hi(bb.z), bf_lo(bb.w), bf_hi(bb.w)} + a1;
                    u32x4 w; w.x = cvt_pk_bf16(o0[0], o0[1]); w.y = cvt_pk_bf16(o0[2], o0[3]); w.z = cvt_pk_bf16(o1[0], o1[1]); w.w = cvt_pk_bf16(o1[2], o1[3]); *(u32x4*)(xb + c) = w;
                    q += ((o0[0] * o0[0] + o0[1] * o0[1]) + (o0[2] * o0[2] + o0[3] * o0[3])) + ((o1[0] * o1[0] + o1[1] * o1[1]) + (o1[2] * o1[2] + o1[3] * o1[3])); }
                q += __shfl_xor(q, 16); q += __shfl_xor(q, 32);
                if (fq == 0) ssqp[(unsigned)row * 16 + u.pn * 4 + wc] = q; }
            asm volatile("" ::: "memory");
        }
    }
};

template <class Epi, class Sched, bool ALIGN_EPI = false, bool SP2 = false, class Pre = NoPre>
__device__ __forceinline__ void gemm_phase(LAS unsigned char* lds, const Gemm g, const Sched& S, const Epi& E, const Pre& pre = Pre()) {
    int tid_ = threadIdx.x; asm volatile("" : "+v"(tid_));
    const int tid = tid_, wid = __builtin_amdgcn_readfirstlane(tid >> 6), lane = tid & 63, wr = wid >> 2, wc = wid & 3, fr = lane & 15, fq = lane >> 4;
    int K_ = g.K; asm volatile("" : "+s"(K_));
    const int K = K_, nt = K / BK;
    unsigned voffA[2], voffB[2];
#pragma unroll
    for (int i = 0; i < 2; ++i) { int R, C; stage_rc(tid * 16 + i * 8192, R, C); const int Rb = Epi::PERM ? ((R & ~31) + perm32(R & 31)) : R;
        voffA[i] = (unsigned)(R * K + C) * 2u; voffB[i] = (unsigned)(Rb * K + C) * 2u; }
    const size_t kstep = (size_t)(BK * 2);
    const size_t hstep = (size_t)HALF * K * 2;
    const size_t tstep = 2 * hstep;
    const unsigned ldsw = (unsigned)wid * 1024u;
    const int aoff = lds_byte(wr * 64 + fr, fq * 8), boff = lds_byte(wc * 32 + fr, fq * 8);
#define PG8_SA(b, h) (((b) * 2 + (h)) * HTB)
#define PG8_SB(b, h) ((4 + (b) * 2 + (h)) * HTB)
#define PG8_STAGE(bufoff, gbase, voff) do { _Pragma("unroll") for (int _i = 0; _i < 2; ++_i) \
        __builtin_amdgcn_global_load_lds((const unsigned*)((const char*)(gbase) + (voff)[_i]), (LAS unsigned*)(lds + (bufoff) + ldsw + _i * 8192), 16, 0, 0); } while (0)
#define PG8_LDA(dst, b, h) do { _Pragma("unroll") for (int m = 0; m < 4; ++m) _Pragma("unroll") for (int k = 0; k < 2; ++k) dst[m][k] = *(const LAS bf16x8*)(lds + PG8_SA(b, h) + aoff + m * 2048 + k * 1024); } while (0)
#define PG8_LDB(dst, b, h) do { _Pragma("unroll") for (int n = 0; n < 2; ++n) _Pragma("unroll") for (int k = 0; k < 2; ++k) dst[n][k] = *(const LAS bf16x8*)(lds + PG8_SB(b, h) + boff + n * 2048 + k * 1024); } while (0)
#define PG8_MMA(ai, bj, At, Bt) do { __builtin_amdgcn_s_setprio(1); _Pragma("unroll") for (int m = 0; m < 4; ++m) _Pragma("unroll") for (int n = 0; n < 2; ++n) _Pragma("unroll") for (int k = 0; k < 2; ++k) \
        acc[ai][bj][m][n] = __builtin_amdgcn_mfma_f32_16x16x32_bf16(Bt[n][k], At[m][k], acc[ai][bj][m][n], 0, 0, 0); __builtin_amdgcn_s_setprio(0); } while (0)
#define PG8_WAIT_V(n) asm volatile("s_waitcnt vmcnt(" #n ")" ::: "memory")
#define PG8_WAIT_L(n) asm volatile("s_waitcnt lgkmcnt(" #n ")" ::: "memory")
#define PG8_BAR __builtin_amdgcn_s_barrier()
#define PG8_SCHED __builtin_amdgcn_sched_barrier(0)
    Unit cur, nxt; int ui = 0;
    if (!S.next(0, cur)) return;
    f32x4 acc[2][2][4][2];
#pragma unroll
    for (int a = 0; a < 2; ++a)
#pragma unroll
        for (int b = 0; b < 2; ++b)
#pragma unroll
            for (int m = 0; m < 4; ++m)
#pragma unroll
                for (int n = 0; n < 2; ++n) acc[a][b][m][n] = (f32x4){0.f, 0.f, 0.f, 0.f};
    bf16x8 At[4][2], B0[2][2], B1[2][2];
    const char* cA = (const char*)g.A + (size_t)(cur.pm >> 4) * g.axs + (size_t)(cur.pm & 15) * tstep; const char* cB = (const char*)g.Bt + (size_t)cur.pn * tstep;
    S.a_ready(cur);
    if constexpr (SP2) {
        PG8_STAGE(PG8_SB(0, 0), cB, voffB); PG8_STAGE(PG8_SB(0, 1), cB + hstep, voffB); PG8_STAGE(PG8_SA(0, 0), cA, voffA); PG8_STAGE(PG8_SA(0, 1), cA + hstep, voffA);
        if (wr == 1) PG8_BAR;
        PG8_WAIT_V(2); PG8_BAR;
        PG8_STAGE(PG8_SB(1, 0), cB + kstep, voffB); PG8_STAGE(PG8_SA(1, 0), cA + kstep, voffA); PG8_STAGE(PG8_SB(1, 1), cB + hstep + kstep, voffB);
        pre(lds, S);
        PG8_WAIT_V(6); PG8_BAR;
    } else {
        PG8_STAGE(PG8_SB(0, 0), cB, voffB); PG8_STAGE(PG8_SA(0, 0), cA, voffA); PG8_STAGE(PG8_SB(0, 1), cB + hstep, voffB); PG8_STAGE(PG8_SA(0, 1), cA + hstep, voffA);
        if (wr == 1) PG8_BAR;
        PG8_WAIT_V(4); PG8_BAR;
        PG8_STAGE(PG8_SB(1, 0), cB + kstep, voffB); PG8_STAGE(PG8_SA(1, 0), cA + kstep, voffA); PG8_STAGE(PG8_SB(1, 1), cB + hstep + kstep, voffB);
        PG8_WAIT_V(6); PG8_BAR;
    }
    for (;;) {
        const bool has_next = S.next(ui + 1, nxt);
        const char* nA = has_next ? (const char*)g.A + (size_t)(nxt.pm >> 4) * g.axs + (size_t)(nxt.pm & 15) * tstep : cA; const char* nB = has_next ? (const char*)g.Bt + (size_t)nxt.pn * tstep : cB;
        for (int t = 0; t < nt; t += 2) {
            const bool last = (t == nt - 2);
            const char* a1 = cA + (size_t)(t + 1) * kstep;
            const char* a2 = last ? nA : cA + (size_t)(t + 2) * kstep; const char* b2 = last ? nB : cB + (size_t)(t + 2) * kstep;
            const char* a3 = a2 + kstep; const char* b3 = b2 + kstep;
            if (last && has_next) S.a_ready(nxt);
            if constexpr (SP2) {
            PG8_LDB(B0, 0, 0); PG8_LDB(B1, 0, 1); PG8_SCHED; PG8_LDA(At, 0, 0); PG8_STAGE(PG8_SA(1, 1), a1 + hstep, voffA);
            PG8_WAIT_V(8);
            PG8_WAIT_L(0); PG8_BAR; PG8_MMA(0, 0, At, B0); PG8_MMA(0, 1, At, B1); PG8_BAR; PG8_SCHED;
            PG8_LDA(At, 0, 1); PG8_STAGE(PG8_SB(0, 0), b2, voffB); PG8_STAGE(PG8_SB(0, 1), b2 + hstep, voffB); PG8_STAGE(PG8_SA(0, 0), a2, voffA);
            PG8_WAIT_V(8);
            PG8_WAIT_L(0); PG8_BAR; PG8_MMA(1, 0, At, B0); PG8_MMA(1, 1, At, B1); PG8_BAR; PG8_SCHED;
            PG8_LDB(B0, 1, 0); PG8_LDB(B1, 1, 1); PG8_SCHED; PG8_LDA(At, 1, 0); PG8_STAGE(PG8_SA(0, 1), a2 + hstep, voffA);
            PG8_WAIT_V(8); PG8_WAIT_L(0); PG8_BAR; PG8_MMA(0, 0, At, B0); PG8_MMA(0, 1, At, B1); PG8_BAR; PG8_SCHED;
            PG8_LDA(At, 1, 1); PG8_STAGE(PG8_SB(1, 0), b3, voffB); PG8_STAGE(PG8_SB(1, 1), b3 + hstep, voffB); PG8_STAGE(PG8_SA(1, 0), a3, voffA);
            PG8_WAIT_V(8); PG8_WAIT_L(0); PG8_BAR; PG8_MMA(1, 0, At, B0); PG8_MMA(1, 1, At, B1); PG8_BAR; PG8_SCHED;
            } else {
            PG8_LDB(B0, 0, 0); PG8_SCHED; PG8_LDA(At, 0, 0); PG8_STAGE(PG8_SA(1, 1), a1 + hstep, voffA);
            PG8_WAIT_L(8); PG8_BAR; PG8_WAIT_L(0); PG8_MMA(0, 0, At, B0); PG8_BAR; PG8_SCHED;
            PG8_LDB(B1, 0, 1); PG8_STAGE(PG8_SB(0, 0), b2, voffB);
            PG8_BAR; PG8_WAIT_L(0); PG8_MMA(0, 1, At, B1); PG8_BAR;
            PG8_LDA(At, 0, 1); PG8_STAGE(PG8_SA(0, 0), a2, voffA);
            PG8_BAR; PG8_WAIT_L(0); PG8_MMA(1, 0, At, B0); PG8_BAR; PG8_SCHED;
            PG8_STAGE(PG8_SB(0, 1), b2 + hstep, voffB);
            PG8_WAIT_V(6); PG8_BAR; PG8_MMA(1, 1, At, B1); PG8_BAR;
            PG8_LDB(B0, 1, 0); PG8_SCHED; PG8_LDA(At, 1, 0); PG8_STAGE(PG8_SA(0, 1), a2 + hstep, voffA);
            PG8_WAIT_L(8); PG8_BAR; PG8_WAIT_L(0); PG8_MMA(0, 0, At, B0); PG8_BAR; PG8_SCHED;
            PG8_LDB(B1, 1, 1); PG8_STAGE(PG8_SB(1, 0), b3, voffB);
            PG8_BAR; PG8_WAIT_L(0); PG8_MMA(0, 1, At, B1); PG8_BAR;
            PG8_LDA(At, 1, 1); PG8_STAGE(PG8_SA(1, 0), a3, voffA);
            PG8_BAR; PG8_WAIT_L(0); PG8_MMA(1, 0, At, B0); PG8_BAR; PG8_SCHED;
            PG8_STAGE(PG8_SB(1, 1), b3 + hstep, voffB);
            PG8_WAIT_V(6); PG8_BAR; PG8_MMA(1, 1, At, B1); PG8_BAR;
            }
        }
        if constexpr (ALIGN_EPI) { if (wr == 0) PG8_BAR; }
        E(acc, cur, ui, lds, wr, wc, fr, fq); S.done(cur);
        if (!has_next) break;
#pragma unroll
        for (int a = 0; a < 2; ++a)
#pragma unroll
            for (int b = 0; b < 2; ++b)
#pragma unroll
                for (int m = 0; m < 4; ++m)
#pragma unroll
                    for (int n = 0; n < 2; ++n) acc[a][b][m][n] = (f32x4){0.f, 0.f, 0.f, 0.f};
        cur = nxt; cA = nA; cB = nB; ++ui;
        if constexpr (ALIGN_EPI) { if (wr == 1) PG8_BAR; }
    }
    PG8_WAIT_V(0);
    if constexpr (!ALIGN_EPI) { if (wr == 0) PG8_BAR; }
    PG8_BAR;
#undef PG8_SA
#undef PG8_SB
#undef PG8_STAGE
#undef PG8_LDA
#undef PG8_LDB
#undef PG8_MMA
#undef PG8_WAIT_V
#undef PG8_WAIT_L
#undef PG8_BAR
#undef PG8_SCHED
}
}

__device__ __forceinline__ void unpack8(const u32x4 r, float (&f)[8]) {
    f[0] = bf_lo(r.x); f[1] = bf_hi(r.x); f[2] = bf_lo(r.y); f[3] = bf_hi(r.y); f[4] = bf_lo(r.z); f[5] = bf_hi(r.z); f[6] = bf_lo(r.w); f[7] = bf_hi(r.w);
}
__device__ __forceinline__ u32x4 pack8(const float (&f)[8]) {
    u32x4 w; w.x = cvt_pk_bf16(f[0], f[1]); w.y = cvt_pk_bf16(f[2], f[3]); w.z = cvt_pk_bf16(f[4], f[5]); w.w = cvt_pk_bf16(f[6], f[7]); return w;
}
__device__ __forceinline__ void gelu8(float (&f)[8]) {
#pragma unroll
    for (int j = 0; j < 8; j += 2) { const f32x2 r = gelu_pk((f32x2){f[j], f[j + 1]}); f[j] = r.x; f[j + 1] = r.y; }
}

constexpr int VNT_STRIDE = 272, VNT_BYTES = 64 * VNT_STRIDE;
__device__ __forceinline__ const bf16_t* prow(const unsigned char* ws, int row) { return (const bf16_t*)(ws + slice_off(row) + SL_PROJ) + (size_t)(row & 4095) * PLD; }
template <int GRP>
__device__ __forceinline__ void pool_group(const unsigned char* __restrict__ ws, bf16_t* __restrict__ Yrow, const bf16_t* __restrict__ wpT, int G, int pos, int fr, int fq) {
    constexpr int win = 2 << GRP;
    f32x4 acc[4];
#pragma unroll
    for (int n = 0; n < 4; ++n) acc[n] = (f32x4){0.f, 0.f, 0.f, 0.f};
    const int cnt = (pos + 1) < win ? (pos + 1) : win;
    const float inv = 1.0f / (float)cnt;
#pragma unroll
    for (int ks = 0; ks < 2; ++ks) {
        const int c = GRP * 64 + ks * 32 + 8 * fq;
        constexpr int NB = win < 8 ? win : 8;
        bf16x8 bfr[4];
#pragma unroll
        for (int n = 0; n < 4; ++n) bfr[n] = *(const bf16x8*)(wpT + GRP * 4096 + (32 * (n >> 1) + 8 * (fr >> 2) + 4 * (n & 1) + (fr & 3)) * 64 + ks * 32 + 8 * fq);
        float s[8], z0[8];
#pragma unroll
        for (int j = 0; j < 8; ++j) { s[j] = 0.f; z0[j] = 0.f; }
#pragma unroll
        for (int j0 = 0; j0 < win; j0 += NB) {
            u32x4 r[NB];
#pragma unroll
            for (int jj = 0; jj < NB; ++jj) r[jj] = *(const u32x4*)(prow(ws, G - ((j0 + jj) < cnt ? (j0 + jj) : 0)) + (GRP < 2 ? OFF_ZC0 : OFF_ZC1 - 128) + c);
#pragma unroll
            for (int jj = 0; jj < NB; ++jj) { float v[8]; unpack8(r[jj], v); const float mk = (j0 + jj) < cnt ? 1.f : 0.f;
#pragma unroll
                for (int j = 0; j < 8; ++j) { s[j] += mk * v[j]; if (j0 + jj == 0) z0[j] = v[j]; } }
            if (j0 + NB < win) asm volatile("" ::: "memory");
        }
        float pl[8];
#pragma unroll
        for (int j = 0; j < 8; ++j) pl[j] = s[j] * inv - z0[j];
        const bf16x8 af = __builtin_bit_cast(bf16x8, pack8(pl));
#pragma unroll
        for (int n = 0; n < 4; ++n) acc[n] = __builtin_amdgcn_mfma_f32_16x16x32_bf16(bfr[n], af, acc[n], 0, 0, 0);
    }
    bf16_t* yp = Yrow + 768 + GRP * 64 + 8 * fq;
#pragma unroll
    for (int k = 0; k < 2; ++k) { u32x4 w; w.x = cvt_pk_bf16(acc[2 * k][0], acc[2 * k][1]); w.y = cvt_pk_bf16(acc[2 * k][2], acc[2 * k][3]); w.z = cvt_pk_bf16(acc[2 * k + 1][0], acc[2 * k + 1][1]); w.w = cvt_pk_bf16(acc[2 * k + 1][2], acc[2 * k + 1][3]); *(u32x4*)(yp + 32 * k) = w; }
}
__device__ __forceinline__ void mixer_chunk(LAS unsigned char* lds, int chunk, unsigned char* __restrict__ ws,
                                            const bf16_t* __restrict__ sguw, const float* __restrict__ sgub, const float* __restrict__ lng, const float* __restrict__ lnb,
                                            const float* __restrict__ convw, const bf16_t* __restrict__ wpT) {
    int tid_ = threadIdx.x; asm volatile("" : "+v"(tid_));
    const int tid = tid_, wid = __builtin_amdgcn_readfirstlane(tid >> 6), lane = tid & 63, fr = lane & 15, fq = lane >> 4;
    const int T0 = chunk * 128;
    const bf16_t* __restrict__ Pc = prow(ws, T0);
    bf16_t* __restrict__ Yc = (bf16_t*)(ws + slice_off(T0) + SL_YCAT) + (size_t)(T0 & 4095) * D;
    {
        const int pr = tid >> 3, q = tid & 7;
        const bf16_t* src = Pc + (size_t)(2 * pr) * PLD + OFF_VA + 8 * q;
#pragma unroll 1
        for (int hb = 0; hb < 6; hb += 3) {
        u32x4 r0[3], r1[3];
#pragma unroll
        for (int hh = 0; hh < 3; ++hh) { r0[hh] = *(const u32x4*)(src + (hb + hh) * 64); r1[hh] = *(const u32x4*)(src + PLD + (hb + hh) * 64); }
#pragma unroll
        for (int hh = 0; hh < 3; ++hh) { const int h = hb + hh;
            LAS unsigned char* buf = lds + h * VNT_BYTES;
            float a[8], b[8]; unpack8(r0[hh], a); unpack8(r1[hh], b); gelu8(a); gelu8(b);
            float s0 = 0.f, s1 = 0.f;
#pragma unroll
            for (int j = 0; j < 8; ++j) { s0 += a[j]; s1 += b[j]; }
            s0 += __shfl_xor(s0, 1); s1 += __shfl_xor(s1, 1); s0 += __shfl_xor(s0, 2); s1 += __shfl_xor(s1, 2); s0 += __shfl_xor(s0, 4); s1 += __shfl_xor(s1, 4);
            const float m0 = s0 * (1.f / 64.f), m1 = s1 * (1.f / 64.f);
            float q0 = 0.f, q1 = 0.f;
#pragma unroll
            for (int j = 0; j < 8; ++j) { a[j] -= m0; b[j] -= m1; q0 += a[j] * a[j]; q1 += b[j] * b[j]; }
            q0 += __shfl_xor(q0, 1); q1 += __shfl_xor(q1, 1); q0 += __shfl_xor(q0, 2); q1 += __shfl_xor(q1, 2); q0 += __shfl_xor(q0, 4); q1 += __shfl_xor(q1, 4);
            const float rs0 = __builtin_amdgcn_rsqf(q0 * (1.f / 64.f) + LN_EPS), rs1 = __builtin_amdgcn_rsqf(q1 * (1.f / 64.f) + LN_EPS);
            const f32x4 g0 = *(const f32x4*)(lng + h * 64 + 8 * q), g1 = *(const f32x4*)(lng + h * 64 + 8 * q + 4);
            const f32x4 c0 = *(const f32x4*)(lnb + h * 64 + 8 * q), c1 = *(const f32x4*)(lnb + h * 64 + 8 * q + 4);
#pragma unroll
            for (int j = 0; j < 8; ++j) {
                const float gg = j < 4 ? g0[j & 3] : g1[j & 3], cc = j < 4 ? c0[j & 3] : c1[j & 3];
                const unsigned w = cvt_pk_bf16(a[j] * rs0 * gg + cc, b[j] * rs1 * gg + cc);
                *(LAS unsigned*)(buf + (8 * q + j) * VNT_STRIDE + pr * 4) = w;
            }
        }
        }
    }
    if (tid < 384) {
        const int strip = tid / 48, grp = tid % 48, ch = grp * 8;
        float w0[8], w1[8], w2[8], hm2[8], hm1[8];
        { const f32x4 a0 = *(const f32x4*)(convw + ch), a1 = *(const f32x4*)(convw + ch + 4), b0 = *(const f32x4*)(convw + 384 + ch), b1 = *(const f32x4*)(convw + 384 + ch + 4),
                      c0 = *(const f32x4*)(convw + 768 + ch), c1 = *(const f32x4*)(convw + 768 + ch + 4);
#pragma unroll
          for (int j = 0; j < 4; ++j) { w0[j] = a0[j]; w0[j + 4] = a1[j]; w1[j] = b0[j]; w1[j + 4] = b1[j]; w2[j] = c0[j]; w2[j + 4] = c1[j]; } }
        const int tg0 = T0 + strip * 16, tl0 = strip * 16;
        {
            const bool first = (tg0 & (SEQ - 1)) == 0;
            const bf16_t* pz = prow(ws, first ? tg0 : tg0 - 2) + ch;
            float z[8]; const float mk = first ? 0.f : 1.f;
            unpack8(*(const u32x4*)(pz + OFF_H), z);
#pragma unroll
            for (int j = 0; j < 8; ++j) hm2[j] = mk * z[j];
            unpack8(*(const u32x4*)(pz + PLD + OFF_H), z);
#pragma unroll
            for (int j = 0; j < 8; ++j) hm1[j] = mk * z[j];
        }
#pragma unroll 1
        for (int i0 = 0; i0 < 16; i0 += 4) {
            u32x4 rz[4], rg[4];
#pragma unroll
            for (int k = 0; k < 4; ++k) { const bf16_t* pz = Pc + (size_t)(tl0 + i0 + k) * PLD + ch; rz[k] = *(const u32x4*)(pz + OFF_H); rg[k] = *(const u32x4*)(pz + OFF_GB); }
#pragma unroll
            for (int k = 0; k < 4; ++k) {
                float z[8], gbv[8], o[8];
                unpack8(rz[k], z); unpack8(rg[k], gbv);
#pragma unroll
                for (int j = 0; j < 8; ++j) { const float hh = z[j]; o[j] = gbv[j] * (w0[j] * hm2[j] + w1[j] * hm1[j] + w2[j] * hh); hm2[j] = hm1[j]; hm1[j] = hh; }
                *(u32x4*)(Yc + (size_t)(tl0 + i0 + k) * D + 384 + ch) = pack8(o);
            }
        }
    }
    __syncthreads();
    {
        const int t0 = 16 * wid, nks = (wid >> 1) + 1, t = t0 + fr;
        const bf16_t* up = Pc + (size_t)t * PLD + OFF_UA + 8 * fq;
        bf16_t* yp = Yc + (size_t)t * D + 8 * fq;
#pragma unroll 2
        for (int h = 0; h < 6; ++h) {
            const LAS unsigned char* buf = lds + h * VNT_BYTES;
            u32x4 uu[2];
#pragma unroll
            for (int k = 0; k < 2; ++k) uu[k] = *(const u32x4*)(up + h * 64 + 32 * k);
            const float bs = sgub[h * 128 + t];
            f32x4 acc[4];
#pragma unroll
            for (int n = 0; n < 4; ++n) acc[n] = (f32x4){0.f, 0.f, 0.f, 0.f};
            const bf16_t* Wr = sguw + h * 16384 + (t0 + fr) * 128 + 8 * fq;
            for (int ks = 0; ks < nks; ++ks) {
                const bf16x8 af = *(const bf16x8*)(Wr + ks * 32);
#pragma unroll
                for (int n = 0; n < 4; ++n) {
                    const bf16x8 bfr = *(const LAS bf16x8*)(buf + (32 * (n >> 1) + 8 * (fr >> 2) + 4 * (n & 1) + (fr & 3)) * VNT_STRIDE + (ks * 32 + 8 * fq) * 2);
                    acc[n] = __builtin_amdgcn_mfma_f32_16x16x32_bf16(bfr, af, acc[n], 0, 0, 0);
                }
            }
#pragma unroll
            for (int k = 0; k < 2; ++k) {
                const f32x2 ga = gelu_pk((f32x2){bf_lo(uu[k].x), bf_hi(uu[k].x)}), gb = gelu_pk((f32x2){bf_lo(uu[k].y), bf_hi(uu[k].y)});
                const f32x2 gc = gelu_pk((f32x2){bf_lo(uu[k].z), bf_hi(uu[k].z)}), gd = gelu_pk((f32x2){bf_lo(uu[k].w), bf_hi(uu[k].w)});
                u32x4 w; w.x = cvt_pk_bf16(ga.x * (acc[2 * k][0] + bs), ga.y * (acc[2 * k][1] + bs)); w.y = cvt_pk_bf16(gb.x * (acc[2 * k][2] + bs), gb.y * (acc[2 * k][3] + bs));
                w.z = cvt_pk_bf16(gc.x * (acc[2 * k + 1][0] + bs), gc.y * (acc[2 * k + 1][1] + bs)); w.w = cvt_pk_bf16(gd.x * (acc[2 * k + 1][2] + bs), gd.y * (acc[2 * k + 1][3] + bs));
                *(u32x4*)(yp + h * 64 + 32 * k) = w;
            }
        }
    }
    {
        const int G = T0 + 16 * wid + fr, pos = G & (SEQ - 1);
        bf16_t* Yrow = Yc + (size_t)(16 * wid + fr) * D;
        pool_group<0>(ws, Yrow, wpT, G, pos, fr, fq); pool_group<1>(ws, Yrow, wpT, G, pos, fr, fq); pool_group<2>(ws, Yrow, wpT, G, pos, fr, fq); pool_group<3>(ws, Yrow, wpT, G, pos, fr, fq);
    }
    __syncthreads();
}

__device__ __forceinline__ float wave_sum(float v) {
#pragma unroll
    for (int o = 1; o < 64; o <<= 1) v += __shfl_xor(v, o);
    return v;
}
template <bool INPROJ = false>
__device__ __forceinline__ void transpose_item(const float* __restrict__ W, const float* __restrict__ gain, int K, int N, bf16_t* __restrict__ WT, LAS float* scr, int item, int lane) {
    const int nblk = N / 32, kb = item / nblk, nb = item % nblk, k0 = 64 * kb, n0 = 32 * nb, n0d = INPROJ ? inproj_row(n0) : n0;
#pragma unroll
    for (int i = 0; i < 32; ++i) { const int kk = 2 * i + (lane >> 5); const float gsc = gain ? gain[k0 + kk] : 1.0f; scr[kk * 33 + (lane & 31)] = W[(size_t)(k0 + kk) * N + n0 + (lane & 31)] * gsc; }
    asm volatile("s_waitcnt lgkmcnt(0)" ::: "memory");
    const int c = lane & 7;
#pragma unroll
    for (int j = 0; j < 4; ++j) { const int n = (lane >> 3) + 8 * j; const LAS float* s = scr + (8 * c) * 33 + n;
        u32x4 o; o.x = cvt_pk_bf16(s[0 * 33], s[1 * 33]); o.y = cvt_pk_bf16(s[2 * 33], s[3 * 33]); o.z = cvt_pk_bf16(s[4 * 33], s[5 * 33]); o.w = cvt_pk_bf16(s[6 * 33], s[7 * 33]);
        *(u32x4*)(WT + (size_t)(n0d + n) * K + k0 + 8 * c) = o; }
    asm volatile("s_waitcnt lgkmcnt(0)" ::: "memory");
}


#define XB_TMO      128
#define XB_XCNT(j)  (256  + 64 * (j))
#define XB_XSUB(j)  (1280 + 64 * (j))
#define XB_XGEN(j)  (2304 + 64 * (j))
#define XB_TOP      3328
#define XB_TOPGEN   3392
#define XCD_BAR_WORDS 3456
#define XB_SPIN_CAP (1u << 22)
__device__ __forceinline__ unsigned xb_ld(unsigned* p)              { return __hip_atomic_load(p, __ATOMIC_RELAXED, __HIP_MEMORY_SCOPE_AGENT); }
__device__ __forceinline__ unsigned xb_add(unsigned* p, unsigned v) { return __hip_atomic_fetch_add(p, v, __ATOMIC_RELAXED, __HIP_MEMORY_SCOPE_AGENT); }
__device__ __forceinline__ unsigned xb_xcc_id() { return (unsigned)__builtin_amdgcn_s_getreg((3 << 11) | 20) & 0xFu; }
#define XB_SPIN(cond, bar) do { unsigned _sp = 0; while (cond) { __builtin_amdgcn_s_sleep(1); \
    if ((++_sp & 255u) == 0u) { if (xb_ld(&(bar)[XB_TMO])) break; if (_sp > XB_SPIN_CAP) { atomicAdd(&(bar)[XB_TMO], 1u); break; } } } } while (0)
struct XcdBarrier { unsigned* bar; unsigned x; volatile LAS unsigned* st; };
__device__ __forceinline__ XcdBarrier xcd_barrier_post(unsigned* bar, volatile LAS unsigned* st) {
    XcdBarrier b; b.bar = bar; b.x = xb_xcc_id(); b.st = st;
    if (threadIdx.x == 0) st[2] = xb_add(&bar[XB_XCNT(b.x)], 1u);
    return b;
}
__device__ __forceinline__ void xcd_barrier_complete(unsigned* bar, unsigned x, unsigned& nloc, unsigned& nx) {
    const unsigned G = gridDim.x * gridDim.y * gridDim.z;
    unsigned sum, cnt, mine, sp = 0u;
    for (;;) {
        sum = 0u; cnt = 0u; mine = 0u;
#pragma unroll
        for (unsigned j = 0; j < 16; ++j) { const unsigned c = xb_ld(&bar[XB_XCNT(j)]); sum += c; cnt += (c > 0u) ? 1u : 0u; mine = (j == x) ? c : mine; }
        if (sum == G) break;
        __builtin_amdgcn_s_sleep(1);
        if ((++sp & 255u) == 0u) { if (xb_ld(&bar[XB_TMO])) break; if (sp > XB_SPIN_CAP) { atomicAdd(&bar[XB_TMO], 1u); break; } }
    }
    nloc = mine > 0u ? mine : 1u; nx = cnt > 0u ? cnt : 1u;
}
__device__ __forceinline__ void xcd_barrier(const XcdBarrier& b, bool local = false) {
    asm volatile("s_waitcnt vmcnt(0)" ::: "memory");
    __syncthreads();
    if (threadIdx.x == 0) {
        unsigned* bar = b.bar;
        __builtin_amdgcn_s_waitcnt(0);
        unsigned nloc = b.st[0], nx = b.st[1];
        if (nloc == 0u) { xcd_barrier_complete(bar, b.x, nloc, nx); b.st[0] = nloc; b.st[1] = nx; }
        const unsigned old = xb_add(&bar[XB_XSUB(b.x)], 1u);
        const unsigned gen = old / nloc;
        if (local) {
            if (old + 1u == (gen + 1u) * nloc) xb_add(&bar[XB_XGEN(b.x)], 1u);
            else XB_SPIN(xb_ld(&bar[XB_XGEN(b.x)]) == gen, bar);
            __builtin_amdgcn_fence(__ATOMIC_ACQUIRE, "agent");
            asm volatile("s_waitcnt vmcnt(0)" ::: "memory");
        } else if (old + 1u == (gen + 1u) * nloc) {
            __builtin_amdgcn_fence(__ATOMIC_RELEASE, "agent");
            asm volatile("s_waitcnt vmcnt(0)" ::: "memory");
            const unsigned og = xb_add(&bar[XB_TOP], 1u);
            const unsigned tg = og / nx;
            if (og + 1u == (tg + 1u) * nx) xb_add(&bar[XB_TOPGEN], 1u);
            else XB_SPIN(xb_ld(&bar[XB_TOPGEN]) == tg, bar);
            __builtin_amdgcn_fence(__ATOMIC_ACQUIRE, "agent");
            xb_add(&bar[XB_XGEN(b.x)], 1u);
            asm volatile("s_waitcnt vmcnt(0)" ::: "memory");
        } else {
            XB_SPIN(xb_ld(&bar[XB_XGEN(b.x)]) == gen, bar);
            __builtin_amdgcn_fence(__ATOMIC_ACQUIRE, "agent");
            asm volatile("s_waitcnt vmcnt(0)" ::: "memory");
        }
    }
    __syncthreads();
}

struct Args { const float* in[19]; float* out; unsigned char* ws; };

__device__ __forceinline__ void prologue(const Args& a, LAS unsigned char* lds) {
    const int tid = threadIdx.x, wave = __builtin_amdgcn_readfirstlane(tid >> 6), lane = tid & 63;
    const int G = gridDim.x, gw = blockIdx.x * 8 + wave, NGW = G * 8;
    const size_t gt = (size_t)blockIdx.x * 512 + tid, NT = (size_t)G * 512;
    unsigned char* ws = a.ws;
    LAS float* scr = (LAS float*)(lds + wave * 16384);
    constexpr int I_IN = 16 * (DIN / 32), I_OUT = 16 * 32, I_FF1 = 16 * (FF / 32), I_FF2 = 64 * 32, I_G = 16 * 32, I_P = 4 * 32, I_L = I_IN + I_OUT + I_FF1 + I_FF2 + I_G + I_P;
    for (int it = gw; it < DEPTH * I_L; it += NGW) {
        const int l = it / I_L; int r = it % I_L; unsigned char* wl = ws + WS_W + (size_t)l * LW;
        if (r < I_IN) { transpose_item<true>(a.in[3] + (size_t)l * D * DIN, a.in[2] + l * D, D, DIN, (bf16_t*)(wl + LW_IN), scr, r, lane); continue; } r -= I_IN;
        if (r < I_OUT) { transpose_item(a.in[11] + (size_t)l * D * D, nullptr, D, D, (bf16_t*)(wl + LW_OUT), scr, r, lane); continue; } r -= I_OUT;
        if (r < I_FF1) { transpose_item(a.in[13] + (size_t)l * D * FF, a.in[12] + l * D, D, FF, (bf16_t*)(wl + LW_FF1), scr, r, lane); continue; } r -= I_FF1;
        if (r < I_FF2) { transpose_item(a.in[14] + (size_t)l * FF * D, nullptr, FF, D, (bf16_t*)(wl + LW_FF2), scr, r, lane); continue; } r -= I_FF2;
        if (r < I_G) { transpose_item(a.in[16] + (size_t)l * D * D, a.in[15] + l * D, D, D, (bf16_t*)(wl + LW_G), scr, r, lane); continue; } r -= I_G;
        transpose_item(a.in[17] + (size_t)l * DPLE * D, nullptr, DPLE, D, (bf16_t*)(wl + LW_P), scr, r, lane);
    }
    for (size_t i = gt; i < (size_t)DEPTH * 16384; i += NT) { const int l = (int)(i >> 14); const size_t j = i & 16383;
        *(u32x4*)(ws + WS_W + (size_t)l * LW + LW_IN + (size_t)DIN * D * 2 + j * 16) = (u32x4){0u, 0u, 0u, 0u}; }
    for (size_t i = gt; i < (size_t)DEPTH * 6 * 16384; i += NT) { const int l = (int)(i / (6 * 16384)); const int r = (int)(i % (6 * 16384)); const int t = (r >> 7) & 127, s = r & 127;
        const float v = s <= t ? a.in[4][i] : 0.f; ((bf16_t*)(ws + WS_W + (size_t)l * LW + LW_SGU))[r] = (bf16_t)(cvt_pk_bf16(v, 0.f) & 0xffffu); }
    for (size_t i = gt; i < (size_t)DEPTH * 16384; i += NT) { const int l = (int)(i >> 14), r = (int)(i & 16383), g = r >> 12, d = (r >> 6) & 63, c = r & 63;
        const float v = a.in[9][(size_t)l * 16384 + g * 4096 + c * 64 + d] * a.in[10][l * 256 + g * 64 + d];
        ((bf16_t*)(ws + WS_W + (size_t)l * LW + LW_POOL))[r] = (bf16_t)(cvt_pk_bf16(v, 0.f) & 0xffffu); }
    for (size_t i = gt; i < 4 * 768; i += NT) ((float*)(ws + WS_SM_SGUB))[i] = a.in[5][i];
    for (size_t i = gt; i < 4 * 384; i += NT) { ((float*)(ws + WS_SM_LNG))[i] = a.in[6][i]; ((float*)(ws + WS_SM_LNB))[i] = a.in[7][i]; }
    for (size_t i = gt; i < 4 * 1152; i += NT) ((float*)(ws + WS_SM_CONV))[i] = a.in[8][i];
    for (size_t i = gt; i < 1024; i += NT) ((float*)(ws + WS_SM_FG))[i] = a.in[18][i];
    { const f32x4* src = (const f32x4*)a.in[1]; u32x4* dst = (u32x4*)(ws + WS_PB);
      constexpr size_t NIT = (size_t)DEPTH * M * DPLE / 8;
      for (size_t i = gt; i < NIT; i += 4 * NT) { f32x4 v0[4], v1[4];
#pragma unroll
          for (int k = 0; k < 4; ++k) { const size_t ii = i + k * NT < NIT ? i + k * NT : i; v0[k] = src[2 * ii]; v1[k] = src[2 * ii + 1]; }
#pragma unroll
          for (int k = 0; k < 4; ++k) { if (i + k * NT < NIT) { u32x4 w; w.x = cvt_pk_bf16(v0[k][0], v0[k][1]); w.y = cvt_pk_bf16(v0[k][2], v0[k][3]); w.z = cvt_pk_bf16(v1[k][0], v1[k][1]); w.w = cvt_pk_bf16(v1[k][2], v1[k][3]); dst[i + k * NT] = w; } } } }
    { bf16_t* xb = (bf16_t*)(ws + WS_XB); float* ssqp = (float*)(ws + WS_SSQ);
      for (int m0 = gw; m0 < M; m0 += 2 * NGW) {
          f32x4 v[2][4];
#pragma unroll
          for (int r = 0; r < 2; ++r) { const f32x4* xr = (const f32x4*)(a.in[0] + (size_t)(m0 + r * NGW) * D) + lane;
#pragma unroll
              for (int j = 0; j < 4; ++j) v[r][j] = xr[64 * j]; }
#pragma unroll
          for (int r = 0; r < 2; ++r) { const int m = m0 + r * NGW; float s = 0.f; u32x2* o8 = (u32x2*)(xb + (size_t)m * D) + lane;
#pragma unroll
              for (int j = 0; j < 4; ++j) { const f32x4 q = v[r][j]; s += (q[0] * q[0] + q[1] * q[1]) + (q[2] * q[2] + q[3] * q[3]); u32x2 w; w.x = cvt_pk_bf16(q[0], q[1]); w.y = cvt_pk_bf16(q[2], q[3]); o8[64 * j] = w; }
              s = wave_sum(s);
              if (lane < 16) ssqp[(size_t)m * 16 + lane] = lane == 0 ? s : 0.f; } } }
}

__device__ __forceinline__ void final_norm(const Args& a, bool fast, int cid) {
    int tid_ = threadIdx.x; asm volatile("" : "+v"(tid_));
    const int tid = tid_, wave = __builtin_amdgcn_readfirstlane(tid >> 6), lane = tid & 63;
    const int per = M / (int)gridDim.x, NGW = fast ? 8 : (int)gridDim.x * 8, gw = fast ? wave : (int)blockIdx.x * 8 + wave;
    const int mbase = fast ? ((cid & 7) * ((int)gridDim.x / 8) + (cid >> 3)) * per : 0, mend = fast ? mbase + per : M;
    const float* ssqp = (const float*)(a.ws + WS_SSQ); const bf16_t* xb = (const bf16_t*)(a.ws + WS_XB);
    f32x4 gv[2][2];
#pragma unroll
    for (int j = 0; j < 2; ++j) { gv[j][0] = ((const f32x4*)(a.ws + WS_SM_FG))[2 * (lane + 64 * j)]; gv[j][1] = ((const f32x4*)(a.ws + WS_SM_FG))[2 * (lane + 64 * j) + 1]; }
    for (int m = mbase + gw; m < mend; m += NGW) {
        const f32x4* sp = (const f32x4*)(ssqp + (size_t)m * 16);
        const f32x4 s4 = (sp[0] + sp[1]) + (sp[2] + sp[3]);
        const float rs = __builtin_amdgcn_rsqf(((s4[0] + s4[1]) + (s4[2] + s4[3])) * (1.0f / D) + RMS_EPS);
        const u32x4* xr = (const u32x4*)(xb + (size_t)m * D); f32x4* orow = (f32x4*)(a.out + (size_t)m * D);
#pragma unroll
        for (int j = 0; j < 2; ++j) { const u32x4 v = xr[lane + 64 * j];
            orow[2 * (lane + 64 * j)] = (f32x4){bf_lo(v.x), bf_hi(v.x), bf_lo(v.y), bf_hi(v.y)} * rs * gv[j][0];
            orow[2 * (lane + 64 * j) + 1] = (f32x4){bf_lo(v.z), bf_hi(v.z), bf_lo(v.w), bf_hi(v.w)} * rs * gv[j][1]; }
    }
}

__global__ void __launch_bounds__(512, 2) fwd_megakernel(Args a) {
    extern __shared__ __attribute__((aligned(16))) unsigned char lds_raw[];
    LAS unsigned char* lds = (LAS unsigned char*)lds_raw;
    cg::grid_group grid = cg::this_grid();
    const int G = gridDim.x;
#define BARRIER(local_) do { XcdBarrier b_; { size_t z_ = 0; asm volatile("" : "+s"(z_)); b_.bar = (unsigned*)(a.ws + z_) + 4096; } b_.x = xb_xcc_id(); b_.st = (volatile LAS unsigned*)(lds + 131072 + 320) + 8; xcd_barrier(b_, (local_)); } while (0)
#define GRID_SYNC() BARRIER(false)
#define XCD_SYNC() BARRIER(fast)
#define PTRS() size_t z_ = 0; asm volatile("" : "+s"(z_)); unsigned char* ws = a.ws + z_;     \
    int l = l_; asm volatile("" : "+s"(l)); unsigned char* wl = ws + WS_W + (size_t)l * LW; bf16_t* xb = (bf16_t*)(ws + WS_XB); (void)wl; (void)xb;

#ifndef PH
#define PH 0xffff
#endif
    volatile LAS unsigned* MISC = (volatile LAS unsigned*)(lds + 131072 + 320);
    if (threadIdx.x < 32) MISC[threadIdx.x] = 0u;
    __syncthreads();
    if (blockIdx.x == 0) for (int i = threadIdx.x; i < XCD_BAR_WORDS; i += 512) __hip_atomic_store((unsigned*)(a.ws) + 4096 + i, 0u, __ATOMIC_RELAXED, __HIP_MEMORY_SCOPE_AGENT);
    asm volatile("s_waitcnt vmcnt(0)" ::: "memory");
    grid.sync();
    asm volatile("s_waitcnt vmcnt(0)" ::: "memory");
    (void)xcd_barrier_post((unsigned*)(a.ws) + 4096, MISC + 8);
#if PH & 1
    prologue(a, lds);
#endif
    GRID_SYNC();
    bool fast; int cid;
    {
        unsigned* bar = (unsigned*)(a.ws) + 4096; bool ok = (G % 8 == 0) && (G / 8) * 8 == G;
#pragma unroll
        for (int j = 0; j < 16; ++j) { const unsigned cj = xb_ld(&bar[XB_XCNT(j)]); ok = ok && (cj == (j < 8 ? (unsigned)(G / 8) : 0u)); }
        __syncthreads();
        const int xcc = (int)xb_xcc_id(), rank = (int)MISC[10];
        fast = __builtin_amdgcn_readfirstlane(ok ? 1 : 0) != 0;
        cid = __builtin_amdgcn_readfirstlane(fast ? 8 * rank + xcc : (int)blockIdx.x);
    }

#pragma unroll 1
    for (int l_ = 0; l_ < DEPTH; ++l_) {
#if PH & 2
        {
            PTRS();
            pg8::Gemm g{xb, (const bf16_t*)(wl + LW_IN), M, DINP, D, (size_t)16 * 256 * D * 2}; pg8::StaticOrder S; S.init(M, DINP, G, cid);
            pg8::EpiProj<0> E{(bf16_t*)(ws + WS_R1 + SL_PROJ), PLD};
            pg8::gemm_phase<pg8::EpiProj<0>, pg8::StaticOrder, true, true, pg8::RsPre>(lds, g, S, E, pg8::RsPre{ws});
        }
#endif
        GRID_SYNC();
#if PH & 4
        { PTRS();
          const int nch = M / 128;
          for (int c = fast ? (cid & 7) * (nch / 8) + (cid >> 3) : cid; c < nch; c += fast ? nch : G)
            mixer_chunk(lds, c, ws, (const bf16_t*)(wl + LW_SGU), (const float*)(ws + WS_SM_SGUB) + l * 768, (const float*)(ws + WS_SM_LNG) + l * 384, (const float*)(ws + WS_SM_LNB) + l * 384, (const float*)(ws + WS_SM_CONV) + l * 1152, (const bf16_t*)(wl + LW_POOL)); }
#endif
        GRID_SYNC();
#if PH & 8
        {
            PTRS();
            pg8::Gemm g{(const bf16_t*)(ws + WS_R1 + SL_YCAT), (const bf16_t*)(wl + LW_OUT), M, D, D, XS}; pg8::StaticOrder S; S.init(M, D, G, cid);
            pg8::EpiRes<false> E{ws};
            pg8::gemm_phase<pg8::EpiRes<false>, pg8::StaticOrder, true, true>(lds, g, S, E);
        }
#endif
        XCD_SYNC();
#if PH & 16
        {
            PTRS();
            pg8::Gemm g{xb, (const bf16_t*)(wl + LW_FF1), M, FF, D, (size_t)16 * 256 * D * 2}; pg8::StaticOrder S; S.init(M, FF, G, cid);
            pg8::EpiProj<1> E{(bf16_t*)(ws + WS_R1 + SL_HID), FF};
            pg8::gemm_phase<pg8::EpiProj<1>, pg8::StaticOrder, true, true, pg8::RsPre>(lds, g, S, E, pg8::RsPre{ws});
        }
#endif
        XCD_SYNC();
#if PH & 32
        {
            PTRS();
            pg8::Gemm g{(const bf16_t*)(ws + WS_R1 + SL_HID), (const bf16_t*)(wl + LW_FF2), M, D, FF, XS}; pg8::StaticOrder S; S.init(M, D, G, cid);
            pg8::EpiRes<false> E{ws};
            pg8::gemm_phase<pg8::EpiRes<false>, pg8::StaticOrder, true, true>(lds, g, S, E);
        }
#endif
        XCD_SYNC();
#if PH & 64
        {
            PTRS();
            pg8::Gemm g{xb, (const bf16_t*)(wl + LW_G), M, D, D, (size_t)16 * 256 * D * 2}; pg8::StaticOrder S; S.init(M, D, G, cid);
            pg8::EpiGate E{ws};
            pg8::gemm_phase<pg8::EpiGate, pg8::StaticOrder, true, true, pg8::RsPre>(lds, g, S, E, pg8::RsPre{ws});
        }
#endif
        XCD_SYNC();
#if PH & 128
        {
            PTRS();
            pg8::Gemm g{(const bf16_t*)(ws + WS_PB) + (size_t)l * M * DPLE, (const bf16_t*)(wl + LW_P), M, D, DPLE, (size_t)16 * 256 * DPLE * 2}; pg8::StaticOrder S; S.init(M, D, G, cid);
            pg8::EpiRes<true> E{ws};
            pg8::gemm_phase<pg8::EpiRes<true>, pg8::StaticOrder, true, true>(lds, g, S, E);
        }
#endif
        XCD_SYNC();
    }
#if PH & 256
    final_norm(a, fast, cid);
#endif
}

extern "C" void kernel_launch(void* const* d_in, const int* in_sizes, int n_in, void* d_out, int out_size, void* d_ws, size_t ws_size, hipStream_t stream) {
    static int grid_blocks = 0;
    if (grid_blocks == 0) {
        if (n_in != 19 || out_size != M * D || ws_size < WS_END) { fprintf(stderr, "kernel_launch: unexpected shapes (n_in %d out %d ws %zu, need %zu)\n", n_in, out_size, ws_size, (size_t)WS_END); grid_blocks = -1; return; }
        int dev = 0, cus = 0, per_cu = 0;
        hipGetDevice(&dev);
        hipDeviceGetAttribute(&cus, hipDeviceAttributeMultiprocessorCount, dev);
        if (hipFuncSetAttribute((const void*)fwd_megakernel, hipFuncAttributeMaxDynamicSharedMemorySize, LDS_BYTES) != hipSuccess) { fprintf(stderr, "kernel_launch: hipFuncSetAttribute failed\n"); grid_blocks = -1; return; }
        if (hipOccupancyMaxActiveBlocksPerMultiprocessor(&per_cu, (const void*)fwd_megakernel, 512, LDS_BYTES) != hipSuccess || per_cu < 1) { fprintf(stderr, "kernel_launch: occupancy query gave %d\n", per_cu); per_cu = 1; }
        (void)hipGetLastError();
        grid_blocks = cus * 1;
    }
    if (grid_blocks < 0) return;
    Args a{};
    for (int i = 0; i < 19; ++i) a.in[i] = (const float*)d_in[i];
    a.out = (float*)d_out; a.ws = (unsigned char*)d_ws;
    void* args[] = {&a};
    hipError_t e = hipLaunchCooperativeKernel((const void*)fwd_megakernel, dim3(grid_blocks), dim3(512), args, LDS_BYTES, stream);
    if (e != hipSuccess) fprintf(stderr, "cooperative launch failed: %s (grid %d)\n", hipGetErrorString(e), grid_blocks);
}
```

```cpp
#include <hip/hip_runtime.h>
#include <hip/hip_cooperative_groups.h>
#include <cstdio>
#include <cstdint>
namespace cg = cooperative_groups;

#define LAS __attribute__((address_space(3)))
typedef unsigned short bf16_t;
typedef short bf16x8 __attribute__((ext_vector_type(8)));
typedef float f32x4 __attribute__((ext_vector_type(4)));
typedef float f32x2 __attribute__((ext_vector_type(2)));
typedef unsigned u32x4 __attribute__((ext_vector_type(4)));
typedef unsigned u32x2 __attribute__((ext_vector_type(2)));

constexpr int M = 32768, SEQ = 16384, D = 1024, DIN = 2176, DINP = 2304, FF = 4096, DPLE = 256, DEPTH = 4;
constexpr int PLD = 1792, OFF_UA = 0, OFF_VA = 384, OFF_GB = 768, OFF_ZC0 = 1152, OFF_H = 1280, OFF_ZC1 = 1664;
__host__ __device__ __forceinline__ int inproj_row(int n) {
    if (n < 768) return n;
    if (n < 1152) { const int j = n - 768; return 1280 + 256 * (j >> 7) + (j & 127); }
    if (n < 1536) return 768 + (n - 1152);
    if (n < 1920) { const int j = n - 1536; return 1280 + 256 * (j >> 7) + 128 + (j & 127); }
    { const int j = n - 1920; return j < 128 ? 1152 + j : 2048 + (j - 128); }
}
constexpr float RMS_EPS = 1e-6f, LN_EPS = 1e-5f;

constexpr size_t MiB = 1u << 20, KiB = 1u << 10;
constexpr size_t WS_W = 1 * MiB, LW = 26 * MiB;
constexpr size_t LW_IN = 0, LW_OUT = 4608 * KiB, LW_FF1 = LW_OUT + 2 * MiB, LW_FF2 = LW_FF1 + 8 * MiB, LW_G = LW_FF2 + 8 * MiB, LW_P = LW_G + 2 * MiB,
                 LW_SGU = LW_P + 512 * KiB, LW_POOL = LW_SGU + 192 * KiB;
static_assert(LW_POOL + 32 * KiB <= LW, "layer weights");
constexpr size_t WS_XB = WS_W + 4 * LW;
constexpr size_t WS_PB = WS_XB + 64 * MiB;
constexpr size_t WS_SSQ = WS_PB + 64 * MiB;
constexpr size_t WS_R1 = WS_SSQ + 2 * MiB;
constexpr size_t XS = 32 * MiB, SL_PROJ = 0, SL_YCAT = 18 * MiB, SL_HID = 0, SL_GATE = 0;
__device__ __forceinline__ size_t slice_off(int row) { return WS_R1 + (size_t)(row >> 12) * XS; }
constexpr size_t WS_END = WS_R1 + 256 * MiB;

constexpr size_t WS_SM_SGUB = 128 * KiB, WS_SM_LNG = 144 * KiB, WS_SM_LNB = 160 * KiB, WS_SM_CONV = 176 * KiB, WS_SM_FG = 208 * KiB;
constexpr int LDS_BYTES = 147456;

typedef __bf16 bf16x2_t __attribute__((ext_vector_type(2)));
__device__ __forceinline__ unsigned cvt_pk_bf16(float lo, float hi) { const f32x2 v = {lo, hi}; return __builtin_bit_cast(unsigned, __builtin_convertvector(v, bf16x2_t)); }
__device__ __forceinline__ float bf_lo(unsigned w) { return __uint_as_float(w << 16); }
__device__ __forceinline__ float bf_hi(unsigned w) { return __uint_as_float(w & 0xffff0000u); }
__device__ __forceinline__ f32x2 gelu_pk(f32x2 v) {
    const f32x2 av = __builtin_elementwise_abs(v), d = av * 0.2316418882f + 1.0f;
    f32x2 t; t.x = __builtin_amdgcn_rcpf(d.x); t.y = __builtin_amdgcn_rcpf(d.y);
    f32x2 q = t * 0.5307027145f + (-0.7265760135f); q = q * t + 0.7107068705f; q = q * t + (-0.142248368f); q = q * t + 0.127414796f; q = q * t;
    const f32x2 s = (v * v) * (-0.72134752044f);
    f32x2 e; e.x = __builtin_amdgcn_exp2f(s.x); e.y = __builtin_amdgcn_exp2f(s.y);
    const f32x2 m = v * (q * e), r = v - m;
    f32x2 o; o.x = v.x < 0.f ? m.x : r.x; o.y = v.y < 0.f ? m.y : r.y; return o;
}

namespace pg8 {
constexpr int BM = 256, BK = 64, HALF = 128, HTB = HALF * BK * 2, STAGE_BYTES = 8 * HTB, NXCD = 8, WGM = 8;
__host__ __device__ __forceinline__ int lds_byte(int r, int c) { const int st = (r >> 4) * 2 + (c >> 5), rr = r & 15, cc = c & 31, ob = rr * 64 + cc * 2; return st * 1024 + (ob ^ (((ob >> 9) & 1) << 5)); }
__host__ __device__ __forceinline__ void stage_rc(int b, int& R, int& C) { const int st = b / 1024, sb = b % 1024, swz = sb ^ (((sb >> 9) & 1) << 5); R = (st >> 1) * 16 + swz / 64; C = (st & 1) * 32 + (swz % 64) / 2; }
__host__ __device__ __forceinline__ int perm32(int rho) { const int n = rho >> 4, i = rho & 15; return 8 * (i >> 2) + 4 * n + (i & 3); }

struct Unit { int pm, pn; };
struct Gemm { const bf16_t* A; const bf16_t* Bt; int M, N, K; size_t axs; };

struct StaticOrder {
    int nM, nN, nwg, G, c;
    __host__ __device__ void init(int M_, int N_, int G_, int c_) { nM = M_ / BM; nN = N_ / BM; nwg = nM * nN; G = G_; c = c_; }
    __host__ __device__ bool next(int i, Unit& u) const {
        const long L = (long)i * G + c; if (L >= nwg) return false;
        int wgid = (int)L; { const int q = nwg / NXCD, r = nwg % NXCD, xcd = wgid % NXCD, off = wgid / NXCD; wgid = (xcd < r ? xcd * (q + 1) : r * (q + 1) + (xcd - r) * q) + off; }
        const int nig = WGM * nN, gid = wgid / nig, fm = gid * WGM, gsz = (nM - fm) < WGM ? (nM - fm) : WGM;
        u.pm = fm + ((wgid % nig) % gsz); u.pn = (wgid % nig) / gsz; return true;
    }
    __device__ __forceinline__ void a_ready(const Unit&) const {}
    __device__ __forceinline__ void done(const Unit&) const {}
};

constexpr int RSL_OFF = 131072 + 1024;
template <class Sched, bool SYNC = true> __device__ __forceinline__ void fill_rs(LAS unsigned char* lds, const Sched& S, const unsigned char* ws) {
    int tid_ = threadIdx.x; asm volatile("" : "+v"(tid_));
    const float* ssqp = (const float*)(ws + WS_SSQ); LAS float* rsl = (LAS float*)(lds + RSL_OFF);
    const int half = tid_ >> 8, r = tid_ & 255;
    Unit u;
    for (int i = half; S.next(i, u); i += 2) {
        const f32x4* sp = (const f32x4*)(ssqp + (unsigned)(u.pm * BM + r) * 16);
        const f32x4 s4 = (sp[0] + sp[1]) + (sp[2] + sp[3]);
        rsl[i * 256 + r] = __builtin_amdgcn_rsqf(((s4[0] + s4[1]) + (s4[2] + s4[3])) * (1.0f / D) + RMS_EPS);
    }
    if (SYNC) __syncthreads();
}
struct NoPre { template <class Sched> __device__ __forceinline__ void operator()(LAS unsigned char*, const Sched&) const {} };
struct RsPre { const unsigned char* ws; template <class Sched> __device__ __forceinline__ void operator()(LAS unsigned char* lds, const Sched& S) const { fill_rs<Sched, false>(lds, S, ws); } };
template <int N> __device__ __forceinline__ void wait_vm() { asm volatile("s_waitcnt vmcnt(%0)" :: "n"(N) : "memory"); }
template <int ACT> struct EpiProj {
    static constexpr bool PERM = true, AFTER_DRAIN = false; static constexpr int NST = 16;
    bf16_t* O; int ldc;
    __device__ __forceinline__ void operator()(const f32x4 (&acc)[2][2][4][2], const Unit& u, int ui, LAS unsigned char* lds, int wr, int wc, int fr, int fq) const {
        const LAS float* rsl = (const LAS float*)(lds + RSL_OFF) + ui * 256 + wr * 64 + fr;
        const int row0 = (u.pm & 15) * BM + wr * 64 + fr, col0 = u.pn * BM + wc * 32 + 8 * fq; bf16_t* Os = O + (size_t)(u.pm >> 4) * (XS / 2);
#pragma unroll
        for (int ai = 0; ai < 2; ++ai)
#pragma unroll
            for (int m = 0; m < 4; ++m) {
                const int row = row0 + ai * HALF + m * 16; const float rs = rsl[ai * HALF + m * 16];
                bf16_t* rowp = Os + (size_t)row * ldc + col0;
                if (ACT == 0 && u.pn >= 5) {
                    const int cw = wc * 32 + 8 * fq; f32x4 v0, v1;
                    if (u.pn < 8) { const float r2 = rs * rs; v0 = acc[ai][0][m][0] * acc[ai][1][m][0] * r2; v1 = acc[ai][0][m][1] * acc[ai][1][m][1] * r2; }
                    else { v0 = acc[ai][0][m][0] * rs; v1 = acc[ai][0][m][1] * rs; }
                    u32x4 w; w.x = cvt_pk_bf16(v0[0], v0[1]); w.y = cvt_pk_bf16(v0[2], v0[3]); w.z = cvt_pk_bf16(v1[0], v1[1]); w.w = cvt_pk_bf16(v1[2], v1[3]);
                    *(u32x4*)(Os + (size_t)row * ldc + (u.pn < 8 ? OFF_H + 128 * (u.pn - 5) : OFF_ZC1) + cw) = w;
                    continue;
                }
#pragma unroll
                for (int bj = 0; bj < 2; ++bj) {
                    f32x4 v0 = acc[ai][bj][m][0] * rs, v1 = acc[ai][bj][m][1] * rs;
                    if (ACT == 1) {
#pragma unroll
                        for (int j = 0; j < 4; ++j) { const float a = fmaxf(v0[j], 0.f), b = fmaxf(v1[j], 0.f); v0[j] = a * a; v1[j] = b * b; }
                    }
                    u32x4 w; w.x = cvt_pk_bf16(v0[0], v0[1]); w.y = cvt_pk_bf16(v0[2], v0[3]); w.z = cvt_pk_bf16(v1[0], v1[1]); w.w = cvt_pk_bf16(v1[2], v1[3]);
                    *(u32x4*)(rowp + bj * HALF) = w;
                }
            }
    }
};
struct EpiGate {
    static constexpr bool PERM = true, AFTER_DRAIN = false; static constexpr int NST = 16;
    unsigned char* ws;
    __device__ __forceinline__ void operator()(const f32x4 (&acc)[2][2][4][2], const Unit& u, int ui, LAS unsigned char* lds, int wr, int wc, int fr, int fq) const {
        const LAS float* rsl = (const LAS float*)(lds + RSL_OFF) + ui * 256 + wr * 64 + fr; bf16_t* gate = (bf16_t*)(ws + WS_R1 + (size_t)(u.pm >> 4) * XS + SL_GATE);
        const int row0 = (u.pm & 15) * BM + wr * 64 + fr, col0 = u.pn * BM + wc * 32 + 8 * fq;
#pragma unroll
        for (int ai = 0; ai < 2; ++ai)
#pragma unroll
            for (int m = 0; m < 4; ++m) {
                const unsigned off = (unsigned)(row0 + ai * HALF + m * 16) * D + col0; const float rs = rsl[ai * HALF + m * 16];
#pragma unroll
                for (int bj = 0; bj < 2; ++bj) {
                    f32x4 v0 = acc[ai][bj][m][0] * rs, v1 = acc[ai][bj][m][1] * rs;
#pragma unroll
                    for (int j = 0; j < 4; ++j) { v0[j] = __builtin_amdgcn_rcpf(1.0f + __builtin_amdgcn_exp2f(-1.44269504089f * v0[j])); v1[j] = __builtin_amdgcn_rcpf(1.0f + __builtin_amdgcn_exp2f(-1.44269504089f * v1[j])); }
                    u32x4 w; w.x = cvt_pk_bf16(v0[0], v0[1]); w.y = cvt_pk_bf16(v0[2], v0[3]); w.z = cvt_pk_bf16(v1[0], v1[1]); w.w = cvt_pk_bf16(v1[2], v1[3]);
                    *(u32x4*)(gate + off + bj * HALF) = w;
                }
            }
    }
};
template <bool GATED> struct EpiRes {
    static constexpr bool PERM = true, AFTER_DRAIN = false; static constexpr int NST = 24;
    unsigned char* ws;
    __device__ __forceinline__ void operator()(const f32x4 (&acc)[2][2][4][2], const Unit& u, int ui, LAS unsigned char* lds, int wr, int wc, int fr, int fq) const {
        bf16_t* xb = (bf16_t*)(ws + WS_XB); float* ssqp = (float*)(ws + WS_SSQ); const bf16_t* gate = (const bf16_t*)(ws + WS_R1 + (size_t)(u.pm >> 4) * XS + SL_GATE) - (size_t)(u.pm >> 4) * 4096 * D;
        const int row0 = u.pm * BM + wr * 64 + fr, col0 = u.pn * BM + wc * 32 + 8 * fq;
#pragma unroll
        for (int ai = 0; ai < 2; ++ai) {
            u32x4 b[4][2], g[4][2];
#pragma unroll
            for (int m = 0; m < 4; ++m) { const unsigned off = (unsigned)(row0 + ai * HALF + m * 16) * D + col0;
#pragma unroll
                for (int bj = 0; bj < 2; ++bj) { const unsigned c = off + bj * HALF; b[m][bj] = *(const u32x4*)(xb + c); if (GATED) g[m][bj] = *(const u32x4*)(gate + c); } }
#pragma unroll
            for (int m = 0; m < 4; ++m) { const int row = row0 + ai * HALF + m * 16; const unsigned off = (unsigned)row * D + col0; float q = 0.f;
#pragma unroll
                for (int bj = 0; bj < 2; ++bj) { const unsigned c = off + bj * HALF; f32x4 a0 = acc[ai][bj][m][0], a1 = acc[ai][bj][m][1];
                    if (GATED) { const u32x4 gg = g[m][bj]; a0[0] *= bf_lo(gg.x); a0[1] *= bf_hi(gg.x); a0[2] *= bf_lo(gg.y); a0[3] *= bf_hi(gg.y); a1[0] *= bf_lo(gg.z); a1[1] *= bf_hi(gg.z); a1[2] *= bf_lo(gg.w); a1[3] *= bf_hi(gg.w); }
                    const u32x4 bb = b[m][bj];
                    const f32x4 o0 = (f32x4){bf_lo(bb.x), bf_hi(bb.x), bf_lo(bb.y), bf_hi(bb.y)} + a0, o1 = (f32x4){bf_lo(bb.z), bf_hi(bb.z), bf_lo(bb.w), bf_hi(bb.w)} + a1;
                    u32x4 w; w.x = cvt_pk_bf16(o0[0], o0[1]); w.y = cvt_pk_bf16(o0[2], o0[3]); w.z = cvt_pk_bf16(o1[0], o1[1]); w.w = cvt_pk_bf16(o1[2], o1[3]); *(u32x4*)(xb + c) = w;
                    q += ((o0[0] * o0[0] + o0[1] * o0[1]) + (o0[2] * o0[2] + o0[3] * o0[3])) + ((o1[0] * o1[0] + o1[1] * o1[1]) + (o1[2] * o1[2] + o1[3] * o1[3])); }
                q += __shfl_xor(q, 16); q += __shfl_xor(q, 32);
                if (fq == 0) ssqp[(unsigned)row * 16 + u.pn * 4 + wc] = q; }
            asm volatile("" ::: "memory");
        }
    }
};

template <class Epi, class Sched, bool ALIGN_EPI = false, bool SP2 = false, class Pre = NoPre>
__device__ __forceinline__ void gemm_phase(LAS unsigned char* lds, const Gemm g, const Sched& S, const Epi& E, const Pre& pre = Pre()) {
    int tid_ = threadIdx.x; asm volatile("" : "+v"(tid_));
    const int tid = tid_, wid = __builtin_amdgcn_readfirstlane(tid >> 6), lane = tid & 63, wr = wid >> 2, wc = wid & 3, fr = lane & 15, fq = lane >> 4;
    int K_ = g.K; asm volatile("" : "+s"(K_));
    const int K = K_, nt = K / BK;
    unsigned voffA[2], voffB[2];
#pragma unroll
    for (int i = 0; i < 2; ++i) { int R, C; stage_rc(tid * 16 + i * 8192, R, C); const int Rb = Epi::PERM ? ((R & ~31) + perm32(R & 31)) : R;
        voffA[i] = (unsigned)(R * K + C) * 2u; voffB[i] = (unsigned)(Rb * K + C) * 2u; }
    const size_t kstep = (size_t)(BK * 2);
    const size_t hstep = (size_t)HALF * K * 2;
    const size_t tstep = 2 * hstep;
    const unsigned ldsw = (unsigned)wid * 1024u;
    const int aoff = lds_byte(wr * 64 + fr, fq * 8), boff = lds_byte(wc * 32 + fr, fq * 8);
#define PG8_SA(b, h) (((b) * 2 + (h)) * HTB)
#define PG8_SB(b, h) ((4 + (b) * 2 + (h)) * HTB)
#define PG8_STAGE(bufoff, gbase, voff) do { _Pragma("unroll") for (int _i = 0; _i < 2; ++_i) \
        __builtin_amdgcn_global_load_lds((const unsigned*)((const char*)(gbase) + (voff)[_i]), (LAS unsigned*)(lds + (bufoff) + ldsw + _i * 8192), 16, 0, 0); } while (0)
#define PG8_LDA(dst, b, h) do { _Pragma("unroll") for (int m = 0; m < 4; ++m) _Pragma("unroll") for (int k = 0; k < 2; ++k) dst[m][k] = *(const LAS bf16x8*)(lds + PG8_SA(b, h) + aoff + m * 2048 + k * 1024); } while (0)
#define PG8_LDB(dst, b, h) do { _Pragma("unroll") for (int n = 0; n < 2; ++n) _Pragma("unroll") for (int k = 0; k < 2; ++k) dst[n][k] = *(const LAS bf16x8*)(lds + PG8_SB(b, h) + boff + n * 2048 + k * 1024); } while (0)
#define PG8_MMA(ai, bj, At, Bt) do { __builtin_amdgcn_s_setprio(1); _Pragma("unroll") for (int m = 0; m < 4; ++m) _Pragma("unroll") for (int n = 0; n < 2; ++n) _Pragma("unroll") for (int k = 0; k < 2; ++k) \
        acc[ai][bj][m][n] = __builtin_amdgcn_mfma_f32_16x16x32_bf16(Bt[n][k], At[m][k], acc[ai][bj][m][n], 0, 0, 0); __builtin_amdgcn_s_setprio(0); } while (0)
#define PG8_WAIT_V(n) asm volatile("s_waitcnt vmcnt(" #n ")" ::: "memory")
#define PG8_WAIT_L(n) asm volatile("s_waitcnt lgkmcnt(" #n ")" ::: "memory")
#define PG8_BAR __builtin_amdgcn_s_barrier()
#define PG8_SCHED __builtin_amdgcn_sched_barrier(0)
    Unit cur, nxt; int ui = 0;
    if (!S.next(0, cur)) return;
    f32x4 acc[2][2][4][2];
#pragma unroll
    for (int a = 0; a < 2; ++a)
#pragma unroll
        for (int b = 0; b < 2; ++b)
#pragma unroll
            for (int m = 0; m < 4; ++m)
#pragma unroll
                for (int n = 0; n < 2; ++n) acc[a][b][m][n] = (f32x4){0.f, 0.f, 0.f, 0.f};
    bf16x8 At[4][2], B0[2][2], B1[2][2];
    const char* cA = (const char*)g.A + (size_t)(cur.pm >> 4) * g.axs + (size_t)(cur.pm & 15) * tstep; const char* cB = (const char*)g.Bt + (size_t)cur.pn * tstep;
    S.a_ready(cur);
    if constexpr (SP2) {
        PG8_STAGE(PG8_SB(0, 0), cB, voffB); PG8_STAGE(PG8_SB(0, 1), cB + hstep, voffB); PG8_STAGE(PG8_SA(0, 0), cA, voffA); PG8_STAGE(PG8_SA(0, 1), cA + hstep, voffA);
        if (wr == 1) PG8_BAR;
        PG8_WAIT_V(2); PG8_BAR;
        PG8_STAGE(PG8_SB(1, 0), cB + kstep, voffB); PG8_STAGE(PG8_SA(1, 0), cA + kstep, voffA); PG8_STAGE(PG8_SB(1, 1), cB + hstep + kstep, voffB);
        pre(lds, S);
        PG8_WAIT_V(6); PG8_BAR;
    } else {
        PG8_STAGE(PG8_SB(0, 0), cB, voffB); PG8_STAGE(PG8_SA(0, 0), cA, voffA); PG8_STAGE(PG8_SB(0, 1), cB + hstep, voffB); PG8_STAGE(PG8_SA(0, 1), cA + hstep, voffA);
        if (wr == 1) PG8_BAR;
        PG8_WAIT_V(4); PG8_BAR;
        PG8_STAGE(PG8_SB(1, 0), cB + kstep, voffB); PG8_STAGE(PG8_SA(1, 0), cA + kstep, voffA); PG8_STAGE(PG8_SB(1, 1), cB + hstep + kstep, voffB);
        PG8_WAIT_V(6); PG8_BAR;
    }
    for (;;) {
        const bool has_next = S.next(ui + 1, nxt);
        const char* nA = has_next ? (const char*)g.A + (size_t)(nxt.pm >> 4) * g.axs + (size_t)(nxt.pm & 15) * tstep : cA; const char* nB = has_next ? (const char*)g.Bt + (size_t)nxt.pn * tstep : cB;
        for (int t = 0; t < nt; t += 2) {
            const bool last = (t == nt - 2);
            const char* a1 = cA + (size_t)(t + 1) * kstep;
            const char* a2 = last ? nA : cA + (size_t)(t + 2) * kstep; const char* b2 = last ? nB : cB + (size_t)(t + 2) * kstep;
            const char* a3 = a2 + kstep; const char* b3 = b2 + kstep;
            if (last && has_next) S.a_ready(nxt);
            if constexpr (SP2) {
            PG8_LDB(B0, 0, 0); PG8_LDB(B1, 0, 1); PG8_SCHED; PG8_LDA(At, 0, 0); PG8_STAGE(PG8_SA(1, 1), a1 + hstep, voffA);
            PG8_WAIT_V(8);
            PG8_WAIT_L(0); PG8_BAR; PG8_MMA(0, 0, At, B0); PG8_MMA(0, 1, At, B1); PG8_BAR; PG8_SCHED;
            PG8_LDA(At, 0, 1); PG8_STAGE(PG8_SB(0, 0), b2, voffB); PG8_STAGE(PG8_SB(0, 1), b2 + hstep, voffB); PG8_STAGE(PG8_SA(0, 0), a2, voffA);
            PG8_WAIT_V(8);
            PG8_WAIT_L(0); PG8_BAR; PG8_MMA(1, 0, At, B0); PG8_MMA(1, 1, At, B1); PG8_BAR; PG8_SCHED;
            PG8_LDB(B0, 1, 0); PG8_LDB(B1, 1, 1); PG8_SCHED; PG8_LDA(At, 1, 0); PG8_STAGE(PG8_SA(0, 1), a2 + hstep, voffA);
            PG8_WAIT_V(8); PG8_WAIT_L(0); PG8_BAR; PG8_MMA(0, 0, At, B0); PG8_MMA(0, 1, At, B1); PG8_BAR; PG8_SCHED;
            PG8_LDA(At, 1, 1); PG8_STAGE(PG8_SB(1, 0), b3, voffB); PG8_STAGE(PG8_SB(1, 1), b3 + hstep, voffB); PG8_STAGE(PG8_SA(1, 0), a3, voffA);
            PG8_WAIT_V(8); PG8_WAIT_L(0); PG8_BAR; PG8_MMA(1, 0, At, B0); PG8_MMA(1, 1, At, B1); PG8_BAR; PG8_SCHED;
            } else {
            PG8_LDB(B0, 0, 0); PG8_SCHED; PG8_LDA(At, 0, 0); PG8_STAGE(PG8_SA(1, 1), a1 + hstep, voffA);
            PG8_WAIT_L(8); PG8_BAR; PG8_WAIT_L(0); PG8_MMA(0, 0, At, B0); PG8_BAR; PG8_SCHED;
            PG8_LDB(B1, 0, 1); PG8_STAGE(PG8_SB(0, 0), b2, voffB);
            PG8_BAR; PG8_WAIT_L(0); PG8_MMA(0, 1, At, B1); PG8_BAR;
            PG8_LDA(At, 0, 1); PG8_STAGE(PG8_SA(0, 0), a2, voffA);
            PG8_BAR; PG8_WAIT_L(0); PG8_MMA(1, 0, At, B0); PG8_BAR; PG8_SCHED;
            PG8_STAGE(PG8_SB(0, 1), b2 + hstep, voffB);
            PG8_WAIT_V(6); PG8_BAR; PG8_MMA(1, 1, At, B1); PG8_BAR;
            PG8_LDB(B0, 1, 0); PG8_SCHED; PG8_LDA(At, 1, 0); PG8_STAGE(PG8_SA(0, 1), a2 + hstep, voffA);
            PG8_WAIT_L(8); PG8_BAR; PG8_WAIT_L(0); PG8_MMA(0, 0, At, B0); PG8_BAR; PG8_SCHED;
            PG8_LDB(B1, 1, 1); PG8_STAGE(PG8_SB(1, 0), b3, voffB);
            PG8_BAR; PG8_WAIT_L(0); PG8_MMA(0, 1, At, B1); PG8_BAR;
            PG8_LDA(At, 1, 1); PG8_STAGE(PG8_SA(1, 0), a3, voffA);
            PG8_BAR; PG8_WAIT_L(0); PG8_MMA(1, 0, At, B0); PG8_BAR; PG8_SCHED;
            PG8_STAGE(PG8_SB(1, 1), b3 + hstep, voffB);
            PG8_WAIT_V(6); PG8_BAR; PG8_MMA(1, 1, At, B1); PG8_BAR;
            }
        }
        if constexpr (ALIGN_EPI) { if (wr == 0) PG8_BAR; }
        E(acc, cur, ui, lds, wr, wc, fr, fq); S.done(cur);
        if (!has_next) break;
#pragma unroll
        for (int a = 0; a < 2; ++a)
#pragma unroll
            for (int b = 0; b < 2; ++b)
#pragma unroll
                for (int m = 0; m < 4; ++m)
#pragma unroll
                    for (int n = 0; n < 2; ++n) acc[a][b][m][n] = (f32x4){0.f, 0.f, 0.f, 0.f};
        cur = nxt; cA = nA; cB = nB; ++ui;
        if constexpr (ALIGN_EPI) { if (wr == 1) PG8_BAR; }
    }
    PG8_WAIT_V(0);
    if constexpr (!ALIGN_EPI) { if (wr == 0) PG8_BAR; }
    PG8_BAR;
#undef PG8_SA
#undef PG8_SB
#undef PG8_STAGE
#undef PG8_LDA
#undef PG8_LDB
#undef PG8_MMA
#undef PG8_WAIT_V
#undef PG8_WAIT_L
#undef PG8_BAR
#undef PG8_SCHED
}
}

__device__ __forceinline__ void unpack8(const u32x4 r, float (&f)[8]) {
    f[0] = bf_lo(r.x); f[1] = bf_hi(r.x); f[2] = bf_lo(r.y); f[3] = bf_hi(r.y); f[4] = bf_lo(r.z); f[5] = bf_hi(r.z); f[6] = bf_lo(r.w); f[7] = bf_hi(r.w);
}
__device__ __forceinline__ u32x4 pack8(const float (&f)[8]) {
    u32x4 w; w.x = cvt_pk_bf16(f[0], f[1]); w.y = cvt_pk_bf16(f[2], f[3]); w.z = cvt_pk_bf16(f[4], f[5]); w.w = cvt_pk_bf16(f[6], f[7]); return w;
}
__device__ __forceinline__ void gelu8(float (&f)[8]) {
#pragma unroll
    for (int j = 0; j < 8; j += 2) { const f32x2 r = gelu_pk((f32x2){f[j], f[j + 1]}); f[j] = r.x; f[j + 1] = r.y; }
}

constexpr int VNT_STRIDE = 272, VNT_BYTES = 64 * VNT_STRIDE;
__device__ __forceinline__ const bf16_t* prow(const unsigned char* ws, int row) { return (const bf16_t*)(ws + slice_off(row) + SL_PROJ) + (size_t)(row & 4095) * PLD; }
template <int GRP>
__device__ __forceinline__ void pool_group(const unsigned char* __restrict__ ws, bf16_t* __restrict__ Yrow, const bf16_t* __restrict__ wpT, int G, int pos, int fr, int fq) {
    constexpr int win = 2 << GRP;
    f32x4 acc[4];
#pragma unroll
    for (int n = 0; n < 4; ++n) acc[n] = (f32x4){0.f, 0.f, 0.f, 0.f};
    const int cnt = (pos + 1) < win ? (pos + 1) : win;
    const float inv = 1.0f / (float)cnt;
#pragma unroll
    for (int ks = 0; ks < 2; ++ks) {
        const int c = GRP * 64 + ks * 32 + 8 * fq;
        constexpr int NB = win < 8 ? win : 8;
        bf16x8 bfr[4];
#pragma unroll
        for (int n = 0; n < 4; ++n) bfr[n] = *(const bf16x8*)(wpT + GRP * 4096 + (32 * (n >> 1) + 8 * (fr >> 2) + 4 * (n & 1) + (fr & 3)) * 64 + ks * 32 + 8 * fq);
        float s[8], z0[8];
#pragma unroll
        for (int j = 0; j < 8; ++j) { s[j] = 0.f; z0[j] = 0.f; }
#pragma unroll
        for (int j0 = 0; j0 < win; j0 += NB) {
            u32x4 r[NB];
#pragma unroll
            for (int jj = 0; jj < NB; ++jj) r[jj] = *(const u32x4*)(prow(ws, G - ((j0 + jj) < cnt ? (j0 + jj) : 0)) + (GRP < 2 ? OFF_ZC0 : OFF_ZC1 - 128) + c);
#pragma unroll
            for (int jj = 0; jj < NB; ++jj) { float v[8]; unpack8(r[jj], v); const float mk = (j0 + jj) < cnt ? 1.f : 0.f;
#pragma unroll
                for (int j = 0; j < 8; ++j) { s[j] += mk * v[j]; if (j0 + jj == 0) z0[j] = v[j]; } }
            if (j0 + NB < win) asm volatile("" ::: "memory");
        }
        float pl[8];
#pragma unroll
        for (int j = 0; j < 8; ++j) pl[j] = s[j] * inv - z0[j];
        const bf16x8 af = __builtin_bit_cast(bf16x8, pack8(pl));
#pragma unroll
        for (int n = 0; n < 4; ++n) acc[n] = __builtin_amdgcn_mfma_f32_16x16x32_bf16(bfr[n], af, acc[n], 0, 0, 0);
    }
    bf16_t* yp = Yrow + 768 + GRP * 64 + 8 * fq;
#pragma unroll
    for (int k = 0; k < 2; ++k) { u32x4 w; w.x = cvt_pk_bf16(acc[2 * k][0], acc[2 * k][1]); w.y = cvt_pk_bf16(acc[2 * k][2], acc[2 * k][3]); w.z = cvt_pk_bf16(acc[2 * k + 1][0], acc[2 * k + 1][1]); w.w = cvt_pk_bf16(acc[2 * k + 1][2], acc[2 * k + 1][3]); *(u32x4*)(yp + 32 * k) = w; }
}
__device__ __forceinline__ void mixer_chunk(LAS unsigned char* lds, int chunk, unsigned char* __restrict__ ws,
                                            const bf16_t* __restrict__ sguw, const float* __restrict__ sgub, const float* __restrict__ lng, const float* __restrict__ lnb,
                                            const float* __restrict__ convw, const bf16_t* __restrict__ wpT) {
    int tid_ = threadIdx.x; asm volatile("" : "+v"(tid_));
    const int tid = tid_, wid = __builtin_amdgcn_readfirstlane(tid >> 6), lane = tid & 63, fr = lane & 15, fq = lane >> 4;
    const int T0 = chunk * 128;
    const bf16_t* __restrict__ Pc = prow(ws, T0);
    bf16_t* __restrict__ Yc = (bf16_t*)(ws + slice_off(T0) + SL_YCAT) + (size_t)(T0 & 4095) * D;
    {
        const int pr = tid >> 3, q = tid & 7;
        const bf16_t* src = Pc + (size_t)(2 * pr) * PLD + OFF_VA + 8 * q;
#pragma unroll 1
        for (int hb = 0; hb < 6; hb += 3) {
        u32x4 r0[3], r1[3];
#pragma unroll
        for (int hh = 0; hh < 3; ++hh) { r0[hh] = *(const u32x4*)(src + (hb + hh) * 64); r1[hh] = *(const u32x4*)(src + PLD + (hb + hh) * 64); }
#pragma unroll
        for (int hh = 0; hh < 3; ++hh) { const int h = hb + hh;
            LAS unsigned char* buf = lds + h * VNT_BYTES;
            float a[8], b[8]; unpack8(r0[hh], a); unpack8(r1[hh], b); gelu8(a); gelu8(b);
            float s0 = 0.f, s1 = 0.f;
#pragma unroll
            for (int j = 0; j < 8; ++j) { s0 += a[j]; s1 += b[j]; }
            s0 += __shfl_xor(s0, 1); s1 += __shfl_xor(s1, 1); s0 += __shfl_xor(s0, 2); s1 += __shfl_xor(s1, 2); s0 += __shfl_xor(s0, 4); s1 += __shfl_xor(s1, 4);
            const float m0 = s0 * (1.f / 64.f), m1 = s1 * (1.f / 64.f);
            float q0 = 0.f, q1 = 0.f;
#pragma unroll
            for (int j = 0; j < 8; ++j) { a[j] -= m0; b[j] -= m1; q0 += a[j] * a[j]; q1 += b[j] * b[j]; }
            q0 += __shfl_xor(q0, 1); q1 += __shfl_xor(q1, 1); q0 += __shfl_xor(q0, 2); q1 += __shfl_xor(q1, 2); q0 += __shfl_xor(q0, 4); q1 += __shfl_xor(q1, 4);
            const float rs0 = __builtin_amdgcn_rsqf(q0 * (1.f / 64.f) + LN_EPS), rs1 = __builtin_amdgcn_rsqf(q1 * (1.f / 64.f) + LN_EPS);
            const f32x4 g0 = *(const f32x4*)(lng + h * 64 + 8 * q), g1 = *(const f32x4*)(lng + h * 64 + 8 * q + 4);
            const f32x4 c0 = *(const f32x4*)(lnb + h * 64 + 8 * q), c1 = *(const f32x4*)(lnb + h * 64 + 8 * q + 4);
#pragma unroll
            for (int j = 0; j < 8; ++j) {
                const float gg = j < 4 ? g0[j & 3] : g1[j & 3], cc = j < 4 ? c0[j & 3] : c1[j & 3];
                const unsigned w = cvt_pk_bf16(a[j] * rs0 * gg + cc, b[j] * rs1 * gg + cc);
                *(LAS unsigned*)(buf + (8 * q + j) * VNT_STRIDE + pr * 4) = w;
            }
        }
        }
    }
    if (tid < 384) {
        const int strip = tid / 48, grp = tid % 48, ch = grp * 8;
        float w0[8], w1[8], w2[8], hm2[8], hm1[8];
        { const f32x4 a0 = *(const f32x4*)(convw + ch), a1 = *(const f32x4*)(convw + ch + 4), b0 = *(const f32x4*)(convw + 384 + ch), b1 = *(const f32x4*)(convw + 384 + ch + 4),
                      c0 = *(const f32x4*)(convw + 768 + ch), c1 = *(const f32x4*)(convw + 768 + ch + 4);
#pragma unroll
          for (int j = 0; j < 4; ++j) { w0[j] = a0[j]; w0[j + 4] = a1[j]; w1[j] = b0[j]; w1[j + 4] = b1[j]; w2[j] = c0[j]; w2[j + 4] = c1[j]; } }
        const int tg0 = T0 + strip * 16, tl0 = strip * 16;
        {
            const bool first = (tg0 & (SEQ - 1)) == 0;
            const bf16_t* pz = prow(ws, first ? tg0 : tg0 - 2) + ch;
            float z[8]; const float mk = first ? 0.f : 1.f;
            unpack8(*(const u32x4*)(pz + OFF_H), z);
#pragma unroll
            for (int j = 0; j < 8; ++j) hm2[j] = mk * z[j];
            unpack8(*(const u32x4*)(pz + PLD + OFF_H), z);
#pragma unroll
            for (int j = 0; j < 8; ++j) hm1[j] = mk * z[j];
        }
#pragma unroll 1
        for (int i0 = 0; i0 < 16; i0 += 4) {
            u32x4 rz[4], rg[4];
#pragma unroll
            for (int k = 0; k < 4; ++k) { const bf16_t* pz = Pc + (size_t)(tl0 + i0 + k) * PLD + ch; rz[k] = *(const u32x4*)(pz + OFF_H); rg[k] = *(const u32x4*)(pz + OFF_GB); }
#pragma unroll
            for (int k = 0; k < 4; ++k) {
                float z[8], gbv[8], o[8];
                unpack8(rz[k], z); unpack8(rg[k], gbv);
#pragma unroll
                for (int j = 0; j < 8; ++j) { const float hh = z[j]; o[j] = gbv[j] * (w0[j] * hm2[j] + w1[j] * hm1[j] + w2[j] * hh); hm2[j] = hm1[j]; hm1[j] = hh; }
                *(u32x4*)(Yc + (size_t)(tl0 + i0 + k) * D + 384 + ch) = pack8(o);
            }
        }
    }
    __syncthreads();
    {
        const int t0 = 16 * wid, nks = (wid >> 1) + 1, t = t0 + fr;
        const bf16_t* up = Pc + (size_t)t * PLD + OFF_UA + 8 * fq;
        bf16_t* yp = Yc + (size_t)t * D + 8 * fq;
#pragma unroll 2
        for (int h = 0; h < 6; ++h) {
            const LAS unsigned char* buf = lds + h * VNT_BYTES;
            u32x4 uu[2];
#pragma unroll
            for (int k = 0; k < 2; ++k) uu[k] = *(const u32x4*)(up + h * 64 + 32 * k);
            const float bs = sgub[h * 128 + t];
            f32x4 acc[4];
#pragma unroll
            for (int n = 0; n < 4; ++n) acc[n] = (f32x4){0.f, 0.f, 0.f, 0.f};
            const bf16_t* Wr = sguw + h * 16384 + (t0 + fr) * 128 + 8 * fq;
            for (int ks = 0; ks < nks; ++ks) {
                const bf16x8 af = *(const bf16x8*)(Wr + ks * 32);
#pragma unroll
                for (int n = 0; n < 4; ++n) {
                    const bf16x8 bfr = *(const LAS bf16x8*)(buf + (32 * (n >> 1) + 8 * (fr >> 2) + 4 * (n & 1) + (fr & 3)) * VNT_STRIDE + (ks * 32 + 8 * fq) * 2);
                    acc[n] = __builtin_amdgcn_mfma_f32_16x16x32_bf16(bfr, af, acc[n], 0, 0, 0);
                }
            }
#pragma unroll
            for (int k = 0; k < 2; ++k) {
                const f32x2 ga = gelu_pk((f32x2){bf_lo(uu[k].x), bf_hi(uu[k].x)}), gb = gelu_pk((f32x2){bf_lo(uu[k].y), bf_hi(uu[k].y)});
                const f32x2 gc = gelu_pk((f32x2){bf_lo(uu[k].z), bf_hi(uu[k].z)}), gd = gelu_pk((f32x2){bf_lo(uu[k].w), bf_hi(uu[k].w)});
                u32x4 w; w.x = cvt_pk_bf16(ga.x * (acc[2 * k][0] + bs), ga.y * (acc[2 * k][1] + bs)); w.y = cvt_pk_bf16(gb.x * (acc[2 * k][2] + bs), gb.y * (acc[2 * k][3] + bs));
                w.z = cvt_pk_bf16(gc.x * (acc[2 * k + 1][0] + bs), gc.y * (acc[2 * k + 1][1] + bs)); w.w = cvt_pk_bf16(gd.x * (acc[2 * k + 1][2] + bs), gd.y * (acc[2 * k + 1][3] + bs));
                *(u32x4*)(yp + h * 64 + 32 * k) = w;
            }
        }
    }
    {
        const int G = T0 + 16 * wid + fr, pos = G & (SEQ - 1);
        bf16_t* Yrow = Yc + (size_t)(16 * wid + fr) * D;
        pool_group<0>(ws, Yrow, wpT, G, pos, fr, fq); pool_group<1>(ws, Yrow, wpT, G, pos, fr, fq); pool_group<2>(ws, Yrow, wpT, G, pos, fr, fq); pool_group<3>(ws, Yrow, wpT, G, pos, fr, fq);
    }
    __syncthreads();
}

__device__ __forceinline__ float wave_sum(float v) {
#pragma unroll
    for (int o = 1; o < 64; o <<= 1) v += __shfl_xor(v, o);
    return v;
}
template <bool INPROJ = false>
__device__ __forceinline__ void transpose_item(const float* __restrict__ W, const float* __restrict__ gain, int K, int N, bf16_t* __restrict__ WT, LAS float* scr, int item, int lane) {
    const int nblk = N / 32, kb = item / nblk, nb = item % nblk, k0 = 64 * kb, n0 = 32 * nb, n0d = INPROJ ? inproj_row(n0) : n0;
#pragma unroll
    for (int i = 0; i < 32; ++i) { const int kk = 2 * i + (lane >> 5); const float gsc = gain ? gain[k0 + kk] : 1.0f; scr[kk * 33 + (lane & 31)] = W[(size_t)(k0 + kk) * N + n0 + (lane & 31)] * gsc; }
    asm volatile("s_waitcnt lgkmcnt(0)" ::: "memory");
    const int c = lane & 7;
#pragma unroll
    for (int j = 0; j < 4; ++j) { const int n = (lane >> 3) + 8 * j; const LAS float* s = scr + (8 * c) * 33 + n;
        u32x4 o; o.x = cvt_pk_bf16(s[0 * 33], s[1 * 33]); o.y = cvt_pk_bf16(s[2 * 33], s[3 * 33]); o.z = cvt_pk_bf16(s[4 * 33], s[5 * 33]); o.w = cvt_pk_bf16(s[6 * 33], s[7 * 33]);
        *(u32x4*)(WT + (size_t)(n0d + n) * K + k0 + 8 * c) = o; }
    asm volatile("s_waitcnt lgkmcnt(0)" ::: "memory");
}


#define XB_TMO      128
#define XB_XCNT(j)  (256  + 64 * (j))
#define XB_XSUB(j)  (1280 + 64 * (j))
#define XB_XGEN(j)  (2304 + 64 * (j))
#define XB_TOP      3328
#define XB_TOPGEN   3392
#define XCD_BAR_WORDS 3456
#define XB_SPIN_CAP (1u << 22)
__device__ __forceinline__ unsigned xb_ld(unsigned* p)              { return __hip_atomic_load(p, __ATOMIC_RELAXED, __HIP_MEMORY_SCOPE_AGENT); }
__device__ __forceinline__ unsigned xb_add(unsigned* p, unsigned v) { return __hip_atomic_fetch_add(p, v, __ATOMIC_RELAXED, __HIP_MEMORY_SCOPE_AGENT); }
__device__ __forceinline__ unsigned xb_xcc_id() { return (unsigned)__builtin_amdgcn_s_getreg((3 << 11) | 20) & 0xFu; }
#define XB_SPIN(cond, bar) do { unsigned _sp = 0; while (cond) { __builtin_amdgcn_s_sleep(1); \
    if ((++_sp & 255u) == 0u) { if (xb_ld(&(bar)[XB_TMO])) break; if (_sp > XB_SPIN_CAP) { atomicAdd(&(bar)[XB_TMO], 1u); break; } } } } while (0)
struct XcdBarrier { unsigned* bar; unsigned x; volatile LAS unsigned* st; };
__device__ __forceinline__ XcdBarrier xcd_barrier_post(unsigned* bar, volatile LAS unsigned* st) {
    XcdBarrier b; b.bar = bar; b.x = xb_xcc_id(); b.st = st;
    if (threadIdx.x == 0) st[2] = xb_add(&bar[XB_XCNT(b.x)], 1u);
    return b;
}
__device__ __forceinline__ void xcd_barrier_complete(unsigned* bar, unsigned x, unsigned& nloc, unsigned& nx) {
    const unsigned G = gridDim.x * gridDim.y * gridDim.z;
    unsigned sum, cnt, mine, sp = 0u;
    for (;;) {
        sum = 0u; cnt = 0u; mine = 0u;
#pragma unroll
        for (unsigned j = 0; j < 16; ++j) { const unsigned c = xb_ld(&bar[XB_XCNT(j)]); sum += c; cnt += (c > 0u) ? 1u : 0u; mine = (j == x) ? c : mine; }
        if (sum == G) break;
        __builtin_amdgcn_s_sleep(1);
        if ((++sp & 255u) == 0u) { if (xb_ld(&bar[XB_TMO])) break; if (sp > XB_SPIN_CAP) { atomicAdd(&bar[XB_TMO], 1u); break; } }
    }
    nloc = mine > 0u ? mine : 1u; nx = cnt > 0u ? cnt : 1u;
}
__device__ __forceinline__ void xcd_barrier(const XcdBarrier& b, bool local = false) {
    asm volatile("s_waitcnt vmcnt(0)" ::: "memory");
    __syncthreads();
    if (threadIdx.x == 0) {
        unsigned* bar = b.bar;
        __builtin_amdgcn_s_waitcnt(0);
        unsigned nloc = b.st[0], nx = b.st[1];
        if (nloc == 0u) { xcd_barrier_complete(bar, b.x, nloc, nx); b.st[0] = nloc; b.st[1] = nx; }
        const unsigned old = xb_add(&bar[XB_XSUB(b.x)], 1u);
        const unsigned gen = old / nloc;
        if (local) {
            if (old + 1u == (gen + 1u) * nloc) xb_add(&bar[XB_XGEN(b.x)], 1u);
            else XB_SPIN(xb_ld(&bar[XB_XGEN(b.x)]) == gen, bar);
            __builtin_amdgcn_fence(__ATOMIC_ACQUIRE, "agent");
            asm volatile("s_waitcnt vmcnt(0)" ::: "memory");
        } else if (old + 1u == (gen + 1u) * nloc) {
            __builtin_amdgcn_fence(__ATOMIC_RELEASE, "agent");
            asm volatile("s_waitcnt vmcnt(0)" ::: "memory");
            const unsigned og = xb_add(&bar[XB_TOP], 1u);
            const unsigned tg = og / nx;
            if (og + 1u == (tg + 1u) * nx) xb_add(&bar[XB_TOPGEN], 1u);
            else XB_SPIN(xb_ld(&bar[XB_TOPGEN]) == tg, bar);
            __builtin_amdgcn_fence(__ATOMIC_ACQUIRE, "agent");
            xb_add(&bar[XB_XGEN(b.x)], 1u);
            asm volatile("s_waitcnt vmcnt(0)" ::: "memory");
        } else {
            XB_SPIN(xb_ld(&bar[XB_XGEN(b.x)]) == gen, bar);
            __builtin_amdgcn_fence(__ATOMIC_ACQUIRE, "agent");
            asm volatile("s_waitcnt vmcnt(0)" ::: "memory");
        }
    }
    __syncthreads();
}

struct Args { const float* in[19]; float* out; unsigned char* ws; };

struct TItem { const float* W; const float* gain; bf16_t* WT; int K, N, k0, n0, n0d; };
__device__ __forceinline__ bool titem_decode(const Args& a, int it, TItem& t) {
    constexpr int I_IN = 16 * (DIN / 32), I_OUT = 16 * 32, I_FF1 = 16 * (FF / 32), I_FF2 = 64 * 32, I_G = 16 * 32, I_P = 4 * 32, I_L = I_IN + I_OUT + I_FF1 + I_FF2 + I_G + I_P;
    if (it >= DEPTH * I_L) return false;
    const int l = it / I_L; int r = it % I_L; unsigned char* wl = a.ws + WS_W + (size_t)l * LW; bool inproj = false;
    if (r < I_IN) { t.W = a.in[3] + (size_t)l * D * DIN; t.gain = a.in[2] + l * D; t.K = D; t.N = DIN; t.WT = (bf16_t*)(wl + LW_IN); inproj = true; }
    else if ((r -= I_IN) < I_OUT) { t.W = a.in[11] + (size_t)l * D * D; t.gain = nullptr; t.K = D; t.N = D; t.WT = (bf16_t*)(wl + LW_OUT); }
    else if ((r -= I_OUT) < I_FF1) { t.W = a.in[13] + (size_t)l * D * FF; t.gain = a.in[12] + l * D; t.K = D; t.N = FF; t.WT = (bf16_t*)(wl + LW_FF1); }
    else if ((r -= I_FF1) < I_FF2) { t.W = a.in[14] + (size_t)l * FF * D; t.gain = nullptr; t.K = FF; t.N = D; t.WT = (bf16_t*)(wl + LW_FF2); }
    else if ((r -= I_FF2) < I_G) { t.W = a.in[16] + (size_t)l * D * D; t.gain = a.in[15] + l * D; t.K = D; t.N = D; t.WT = (bf16_t*)(wl + LW_G); }
    else { r -= I_G; t.W = a.in[17] + (size_t)l * DPLE * D; t.gain = nullptr; t.K = DPLE; t.N = D; t.WT = (bf16_t*)(wl + LW_P); }
    const int nblk = t.N / 32, kb = r / nblk, nb = r % nblk; t.k0 = 64 * kb; t.n0 = 32 * nb; t.n0d = inproj ? inproj_row(t.n0) : t.n0;
    return true;
}
__device__ __forceinline__ void titem_load(const TItem& t, int lane, float (&v)[32]) {
#pragma unroll
    for (int i = 0; i < 32; ++i) { const int kk = 2 * i + (lane >> 5); const float gsc = t.gain ? t.gain[t.k0 + kk] : 1.0f; v[i] = t.W[(size_t)(t.k0 + kk) * t.N + t.n0 + (lane & 31)] * gsc; }
}
__device__ __forceinline__ void titem_store(const TItem& t, int lane, const float (&v)[32], LAS float* scr) {
#pragma unroll
    for (int i = 0; i < 32; ++i) scr[(2 * i + (lane >> 5)) * 33 + (lane & 31)] = v[i];
    asm volatile("s_waitcnt lgkmcnt(0)" ::: "memory");
    const int c = lane & 7;
#pragma unroll
    for (int j = 0; j < 4; ++j) { const int n = (lane >> 3) + 8 * j; const LAS float* sp = scr + (8 * c) * 33 + n;
        u32x4 o; o.x = cvt_pk_bf16(sp[0 * 33], sp[1 * 33]); o.y = cvt_pk_bf16(sp[2 * 33], sp[3 * 33]); o.z = cvt_pk_bf16(sp[4 * 33], sp[5 * 33]); o.w = cvt_pk_bf16(sp[6 * 33], sp[7 * 33]);
        *(u32x4*)(t.WT + (size_t)(t.n0d + n) * t.K + t.k0 + 8 * c) = o; }
    asm volatile("s_waitcnt lgkmcnt(0)" ::: "memory");
}


__device__ __forceinline__ void prologue(const Args& a, LAS unsigned char* lds) {
    const int tid = threadIdx.x, wave = __builtin_amdgcn_readfirstlane(tid >> 6), lane = tid & 63;
    const int G = gridDim.x, gw = blockIdx.x * 8 + wave, NGW = G * 8;
    const size_t gt = (size_t)blockIdx.x * 512 + tid, NT = (size_t)G * 512;
    unsigned char* ws = a.ws;
    LAS float* scr = (LAS float*)(lds + wave * 16384);
    {
        TItem cur, nxt; float vc[32], vn[32];
        if (titem_decode(a, gw, cur)) {
            titem_load(cur, lane, vc);
            for (int it = gw + NGW;; it += NGW) {
                const bool more = titem_decode(a, it, nxt);
                if (more) titem_load(nxt, lane, vn);
                titem_store(cur, lane, vc, scr);
                if (!more) break;
                cur = nxt;
#pragma unroll
                for (int i = 0; i < 32; ++i) vc[i] = vn[i];
            }
        }
    }
    for (size_t i = gt; i < (size_t)DEPTH * 16384; i += NT) { const int l = (int)(i >> 14); const size_t j = i & 16383;
        *(u32x4*)(ws + WS_W + (size_t)l * LW + LW_IN + (size_t)DIN * D * 2 + j * 16) = (u32x4){0u, 0u, 0u, 0u}; }
    for (size_t i = gt; i < (size_t)DEPTH * 6 * 16384; i += NT) { const int l = (int)(i / (6 * 16384)); const int r = (int)(i % (6 * 16384)); const int t = (r >> 7) & 127, s = r & 127;
        const float v = s <= t ? a.in[4][i] : 0.f; ((bf16_t*)(ws + WS_W + (size_t)l * LW + LW_SGU))[r] = (bf16_t)(cvt_pk_bf16(v, 0.f) & 0xffffu); }
    for (size_t i = gt; i < (size_t)DEPTH * 16384; i += NT) { const int l = (int)(i >> 14), r = (int)(i & 16383), g = r >> 12, d = (r >> 6) & 63, c = r & 63;
        const float v = a.in[9][(size_t)l * 16384 + g * 4096 + c * 64 + d] * a.in[10][l * 256 + g * 64 + d];
        ((bf16_t*)(ws + WS_W + (size_t)l * LW + LW_POOL))[r] = (bf16_t)(cvt_pk_bf16(v, 0.f) & 0xffffu); }
    for (size_t i = gt; i < 4 * 768; i += NT) ((float*)(ws + WS_SM_SGUB))[i] = a.in[5][i];
    for (size_t i = gt; i < 4 * 384; i += NT) { ((float*)(ws + WS_SM_LNG))[i] = a.in[6][i]; ((float*)(ws + WS_SM_LNB))[i] = a.in[7][i]; }
    for (size_t i = gt; i < 4 * 1152; i += NT) ((float*)(ws + WS_SM_CONV))[i] = a.in[8][i];
    for (size_t i = gt; i < 1024; i += NT) ((float*)(ws + WS_SM_FG))[i] = a.in[18][i];
    { const f32x4* src = (const f32x4*)a.in[1]; u32x4* dst = (u32x4*)(ws + WS_PB);
      constexpr size_t NIT = (size_t)DEPTH * M * DPLE / 8;
      for (size_t i = gt; i < NIT; i += 4 * NT) { f32x4 v0[4], v1[4];
#pragma unroll
          for (int k = 0; k < 4; ++k) { const size_t ii = i + k * NT < NIT ? i + k * NT : i; v0[k] = src[2 * ii]; v1[k] = src[2 * ii + 1]; }
#pragma unroll
          for (int k = 0; k < 4; ++k) { if (i + k * NT < NIT) { u32x4 w; w.x = cvt_pk_bf16(v0[k][0], v0[k][1]); w.y = cvt_pk_bf16(v0[k][2], v0[k][3]); w.z = cvt_pk_bf16(v1[k][0], v1[k][1]); w.w = cvt_pk_bf16(v1[k][2], v1[k][3]); dst[i + k * NT] = w; } } } }
    { bf16_t* xb = (bf16_t*)(ws + WS_XB); float* ssqp = (float*)(ws + WS_SSQ);
      for (int m0 = gw; m0 < M; m0 += 2 * NGW) {
          f32x4 v[2][4];
#pragma unroll
          for (int r = 0; r < 2; ++r) { const f32x4* xr = (const f32x4*)(a.in[0] + (size_t)(m0 + r * NGW) * D) + lane;
#pragma unroll
              for (int j = 0; j < 4; ++j) v[r][j] = xr[64 * j]; }
#pragma unroll
          for (int r = 0; r < 2; ++r) { const int m = m0 + r * NGW; float s = 0.f; u32x2* o8 = (u32x2*)(xb + (size_t)m * D) + lane;
#pragma unroll
              for (int j = 0; j < 4; ++j) { const f32x4 q = v[r][j]; s += (q[0] * q[0] + q[1] * q[1]) + (q[2] * q[2] + q[3] * q[3]); u32x2 w; w.x = cvt_pk_bf16(q[0], q[1]); w.y = cvt_pk_bf16(q[2], q[3]); o8[64 * j] = w; }
              s = wave_sum(s);
              if (lane < 16) ssqp[(size_t)m * 16 + lane] = lane == 0 ? s : 0.f; } } }
}

__device__ __forceinline__ void final_norm(const Args& a, bool fast, int cid) {
    int tid_ = threadIdx.x; asm volatile("" : "+v"(tid_));
    const int tid = tid_, wave = __builtin_amdgcn_readfirstlane(tid >> 6), lane = tid & 63;
    const int per = M / (int)gridDim.x, NGW = fast ? 8 : (int)gridDim.x * 8, gw = fast ? wave : (int)blockIdx.x * 8 + wave;
    const int mbase = fast ? ((cid & 7) * ((int)gridDim.x / 8) + (cid >> 3)) * per : 0, mend = fast ? mbase + per : M;
    const float* ssqp = (const float*)(a.ws + WS_SSQ); const bf16_t* xb = (const bf16_t*)(a.ws + WS_XB);
    f32x4 gv[2][2];
#pragma unroll
    for (int j = 0; j < 2; ++j) { gv[j][0] = ((const f32x4*)(a.ws + WS_SM_FG))[2 * (lane + 64 * j)]; gv[j][1] = ((const f32x4*)(a.ws + WS_SM_FG))[2 * (lane + 64 * j) + 1]; }
    for (int m = mbase + gw; m < mend; m += NGW) {
        const f32x4* sp = (const f32x4*)(ssqp + (size_t)m * 16);
        const f32x4 s4 = (sp[0] + sp[1]) + (sp[2] + sp[3]);
        const float rs = __builtin_amdgcn_rsqf(((s4[0] + s4[1]) + (s4[2] + s4[3])) * (1.0f / D) + RMS_EPS);
        const u32x4* xr = (const u32x4*)(xb + (size_t)m * D); f32x4* orow = (f32x4*)(a.out + (size_t)m * D);
#pragma unroll
        for (int j = 0; j < 2; ++j) { const u32x4 v = xr[lane + 64 * j];
            orow[2 * (lane + 64 * j)] = (f32x4){bf_lo(v.x), bf_hi(v.x), bf_lo(v.y), bf_hi(v.y)} * rs * gv[j][0];
            orow[2 * (lane + 64 * j) + 1] = (f32x4){bf_lo(v.z), bf_hi(v.z), bf_lo(v.w), bf_hi(v.w)} * rs * gv[j][1]; }
    }
}

__global__ void __launch_bounds__(512, 2) fwd_megakernel(Args a) {
    extern __shared__ __attribute__((aligned(16))) unsigned char lds_raw[];
    LAS unsigned char* lds = (LAS unsigned char*)lds_raw;
    cg::grid_group grid = cg::this_grid();
    const int G = gridDim.x;
#define BARRIER(local_) do { XcdBarrier b_; { size_t z_ = 0; asm volatile("" : "+s"(z_)); b_.bar = (unsigned*)(a.ws + z_) + 4096; } b_.x = xb_xcc_id(); b_.st = (volatile LAS unsigned*)(lds + 131072 + 320) + 8; xcd_barrier(b_, (local_)); } while (0)
#define GRID_SYNC() BARRIER(false)
#define XCD_SYNC() BARRIER(fast)
#define PTRS() size_t z_ = 0; asm volatile("" : "+s"(z_)); unsigned char* ws = a.ws + z_;     \
    int l = l_; asm volatile("" : "+s"(l)); unsigned char* wl = ws + WS_W + (size_t)l * LW; bf16_t* xb = (bf16_t*)(ws + WS_XB); (void)wl; (void)xb;

#ifndef PH
#define PH 0xffff
#endif
    volatile LAS unsigned* MISC = (volatile LAS unsigned*)(lds + 131072 + 320);
    if (threadIdx.x < 32) MISC[threadIdx.x] = 0u;
    __syncthreads();
    if (blockIdx.x == 0) for (int i = threadIdx.x; i < XCD_BAR_WORDS; i += 512) __hip_atomic_store((unsigned*)(a.ws) + 4096 + i, 0u, __ATOMIC_RELAXED, __HIP_MEMORY_SCOPE_AGENT);
    asm volatile("s_waitcnt vmcnt(0)" ::: "memory");
    grid.sync();
    asm volatile("s_waitcnt vmcnt(0)" ::: "memory");
    (void)xcd_barrier_post((unsigned*)(a.ws) + 4096, MISC + 8);
#if PH & 1
    prologue(a, lds);
#endif
    GRID_SYNC();
    bool fast; int cid;
    {
        unsigned* bar = (unsigned*)(a.ws) + 4096; bool ok = (G % 8 == 0) && (G / 8) * 8 == G;
#pragma unroll
        for (int j = 0; j < 16; ++j) { const unsigned cj = xb_ld(&bar[XB_XCNT(j)]); ok = ok && (cj == (j < 8 ? (unsigned)(G / 8) : 0u)); }
        __syncthreads();
        const int xcc = (int)xb_xcc_id(), rank = (int)MISC[10];
        fast = __builtin_amdgcn_readfirstlane(ok ? 1 : 0) != 0;
        cid = __builtin_amdgcn_readfirstlane(fast ? 8 * rank + xcc : (int)blockIdx.x);
    }

#pragma unroll 1
    for (int l_ = 0; l_ < DEPTH; ++l_) {
#if PH & 2
        {
            PTRS();
            pg8::Gemm g{xb, (const bf16_t*)(wl + LW_IN), M, DINP, D, (size_t)16 * 256 * D * 2}; pg8::StaticOrder S; S.init(M, DINP, G, cid);
            pg8::EpiProj<0> E{(bf16_t*)(ws + WS_R1 + SL_PROJ), PLD};
            pg8::gemm_phase<pg8::EpiProj<0>, pg8::StaticOrder, true, true, pg8::RsPre>(lds, g, S, E, pg8::RsPre{ws});
        }
#endif
        GRID_SYNC();
#if PH & 4
        { PTRS();
          const int nch = M / 128;
          for (int c = fast ? (cid & 7) * (nch / 8) + (cid >> 3) : cid; c < nch; c += fast ? nch : G)
            mixer_chunk(lds, c, ws, (const bf16_t*)(wl + LW_SGU), (const float*)(ws + WS_SM_SGUB) + l * 768, (const float*)(ws + WS_SM_LNG) + l * 384, (const float*)(ws + WS_SM_LNB) + l * 384, (const float*)(ws + WS_SM_CONV) + l * 1152, (const bf16_t*)(wl + LW_POOL)); }
#endif
        GRID_SYNC();
#if PH & 8
        {
            PTRS();
            pg8::Gemm g{(const bf16_t*)(ws + WS_R1 + SL_YCAT), (const bf16_t*)(wl + LW_OUT), M, D, D, XS}; pg8::StaticOrder S; S.init(M, D, G, cid);
            pg8::EpiRes<false> E{ws};
            pg8::gemm_phase<pg8::EpiRes<false>, pg8::StaticOrder, true, true>(lds, g, S, E);
        }
#endif
        XCD_SYNC();
#if PH & 16
        {
            PTRS();
            pg8::Gemm g{xb, (const bf16_t*)(wl + LW_FF1), M, FF, D, (size_t)16 * 256 * D * 2}; pg8::StaticOrder S; S.init(M, FF, G, cid);
            pg8::EpiProj<1> E{(bf16_t*)(ws + WS_R1 + SL_HID), FF};
            pg8::gemm_phase<pg8::EpiProj<1>, pg8::StaticOrder, true, true, pg8::RsPre>(lds, g, S, E, pg8::RsPre{ws});
        }
#endif
        XCD_SYNC();
#if PH & 32
        {
            PTRS();
            pg8::Gemm g{(const bf16_t*)(ws + WS_R1 + SL_HID), (const bf16_t*)(wl + LW_FF2), M, D, FF, XS}; pg8::StaticOrder S; S.init(M, D, G, cid);
            pg8::EpiRes<false> E{ws};
            pg8::gemm_phase<pg8::EpiRes<false>, pg8::StaticOrder, true, true>(lds, g, S, E);
        }
#endif
        XCD_SYNC();
#if PH & 64
        {
            PTRS();
            pg8::Gemm g{xb, (const bf16_t*)(wl + LW_G), M, D, D, (size_t)16 * 256 * D * 2}; pg8::StaticOrder S; S.init(M, D, G, cid);
            pg8::EpiGate E{ws};
            pg8::gemm_phase<pg8::EpiGate, pg8::StaticOrder, true, true, pg8::RsPre>(lds, g, S, E, pg8::RsPre{ws});
        }
#endif
        XCD_SYNC();
#if PH & 128
        {
            PTRS();
            pg8::Gemm g{(const bf16_t*)(ws + WS_PB) + (size_t)l * M * DPLE, (const bf16_t*)(wl + LW_P), M, D, DPLE, (size_t)16 * 256 * DPLE * 2}; pg8::StaticOrder S; S.init(M, D, G, cid);
            pg8::EpiRes<true> E{ws};
            pg8::gemm_phase<pg8::EpiRes<true>, pg8::StaticOrder, true, true>(lds, g, S, E);
        }
#endif
        XCD_SYNC();
    }
#if PH & 256
    final_norm(a, fast, cid);
#endif
}

extern "C" void kernel_launch(void* const* d_in, const int* in_sizes, int n_in, void* d_out, int out_size, void* d_ws, size_t ws_size, hipStream_t stream) {
    static int grid_blocks = 0;
    if (grid_blocks == 0) {
        if (n_in != 19 || out_size != M * D || ws_size < WS_END) { fprintf(stderr, "kernel_launch: unexpected shapes (n_in %d out %d ws %zu, need %zu)\n", n_in, out_size, ws_size, (size_t)WS_END); grid_blocks = -1; return; }
        int dev = 0, cus = 0, per_cu = 0;
        hipGetDevice(&dev);
        hipDeviceGetAttribute(&cus, hipDeviceAttributeMultiprocessorCount, dev);
        if (hipFuncSetAttribute((const void*)fwd_megakernel, hipFuncAttributeMaxDynamicSharedMemorySize, LDS_BYTES) != hipSuccess) { fprintf(stderr, "kernel_launch: hipFuncSetAttribute failed\n"); grid_blocks = -1; return; }
        if (hipOccupancyMaxActiveBlocksPerMultiprocessor(&per_cu, (const void*)fwd_megakernel, 512, LDS_BYTES) != hipSuccess || per_cu < 1) { fprintf(stderr, "kernel_launch: occupancy query gave %d\n", per_cu); per_cu = 1; }
        (void)hipGetLastError();
        grid_blocks = cus * 1;
    }
    if (grid_blocks < 0) return;
    Args a{};
    for (int i = 0; i < 19; ++i) a.in[i] = (const float*)d_in[i];
    a.out = (float*)d_out; a.ws = (unsigned char*)d_ws;
    void* args[] = {&a};
    hipError_t e = hipLaunchCooperativeKernel((const void*)fwd_megakernel, dim3(grid_blocks), dim3(512), args, LDS_BYTES, stream);
    if (e != hipSuccess) fprintf(stderr, "cooperative launch failed: %s (grid %d)\n", hipGetErrorString(e), grid_blocks);
}
```

```cpp
#include <hip/hip_runtime.h>
#include <hip/hip_cooperative_groups.h>
#include <cstdio>
#include <cstdint>
namespace cg = cooperative_groups;

#define LAS __attribute__((address_space(3)))
typedef unsigned short bf16_t;
typedef short bf16x8 __attribute__((ext_vector_type(8)));
typedef float f32x4 __attribute__((ext_vector_type(4)));
typedef float f32x2 __attribute__((ext_vector_type(2)));
typedef unsigned u32x4 __attribute__((ext_vector_type(4)));
typedef unsigned u32x2 __attribute__((ext_vector_type(2)));

constexpr int M = 32768, SEQ = 16384, D = 1024, DIN = 2176, DINP = 2304, FF = 4096, DPLE = 256, DEPTH = 4;
constexpr int PLD = 1792, OFF_UA = 0, OFF_VA = 384, OFF_GB = 768, OFF_ZC0 = 1152, OFF_H = 1280, OFF_ZC1 = 1664;
__host__ __device__ __forceinline__ int inproj_row(int n) {
    if (n < 768) return n;
    if (n < 1152) { const int j = n - 768; return 1280 + 256 * (j >> 7) + (j & 127); }
    if (n < 1536) return 768 + (n - 1152);
    if (n < 1920) { const int j = n - 1536; return 1280 + 256 * (j >> 7) + 128 + (j & 127); }
    { const int j = n - 1920; return j < 128 ? 1152 + j : 2048 + (j - 128); }
}
constexpr float RMS_EPS = 1e-6f, LN_EPS = 1e-5f;

constexpr size_t MiB = 1u << 20, KiB = 1u << 10;
constexpr size_t WS_W = 1 * MiB, LW = 26 * MiB;
constexpr size_t LW_IN = 0, LW_OUT = 4608 * KiB, LW_FF1 = LW_OUT + 2 * MiB, LW_FF2 = LW_FF1 + 8 * MiB, LW_G = LW_FF2 + 8 * MiB, LW_P = LW_G + 2 * MiB,
                 LW_SGU = LW_P + 512 * KiB, LW_POOL = LW_SGU + 192 * KiB;
static_assert(LW_POOL + 32 * KiB <= LW, "layer weights");
constexpr size_t WS_XB = WS_W + 4 * LW;
constexpr size_t WS_PB = WS_XB + 64 * MiB;
constexpr size_t WS_SSQ = WS_PB + 64 * MiB;
constexpr size_t WS_R1 = WS_SSQ + 2 * MiB;
constexpr size_t XS = 32 * MiB, SL_PROJ = 0, SL_YCAT = 18 * MiB, SL_HID = 0, SL_GATE = 0;
__device__ __forceinline__ size_t slice_off(int row) { return WS_R1 + (size_t)(row >> 12) * XS; }
constexpr size_t WS_END = WS_R1 + 256 * MiB;

constexpr size_t WS_SM_SGUB = 128 * KiB, WS_SM_LNG = 144 * KiB, WS_SM_LNB = 160 * KiB, WS_SM_CONV = 176 * KiB, WS_SM_FG = 208 * KiB;
constexpr int LDS_BYTES = 147456;

typedef __bf16 bf16x2_t __attribute__((ext_vector_type(2)));
__device__ __forceinline__ unsigned cvt_pk_bf16(float lo, float hi) { const f32x2 v = {lo, hi}; return __builtin_bit_cast(unsigned, __builtin_convertvector(v, bf16x2_t)); }
__device__ __forceinline__ float bf_lo(unsigned w) { return __uint_as_float(w << 16); }
__device__ __forceinline__ float bf_hi(unsigned w) { return __uint_as_float(w & 0xffff0000u); }
__device__ __forceinline__ f32x2 gelu_pk(f32x2 v) {
    const f32x2 av = __builtin_elementwise_abs(v), d = av * 0.2316418882f + 1.0f;
    f32x2 t; t.x = __builtin_amdgcn_rcpf(d.x); t.y = __builtin_amdgcn_rcpf(d.y);
    f32x2 q = t * 0.5307027145f + (-0.7265760135f); q = q * t + 0.7107068705f; q = q * t + (-0.142248368f); q = q * t + 0.127414796f; q = q * t;
    const f32x2 s = (v * v) * (-0.72134752044f);
    f32x2 e; e.x = __builtin_amdgcn_exp2f(s.x); e.y = __builtin_amdgcn_exp2f(s.y);
    const f32x2 m = v * (q * e), r = v - m;
    f32x2 o; o.x = v.x < 0.f ? m.x : r.x; o.y = v.y < 0.f ? m.y : r.y; return o;
}

namespace pg8 {
constexpr int BM = 256, BK = 64, HALF = 128, HTB = HALF * BK * 2, STAGE_BYTES = 8 * HTB, NXCD = 8, WGM = 8;
__host__ __device__ __forceinline__ int lds_byte(int r, int c) { const int st = (r >> 4) * 2 + (c >> 5), rr = r & 15, cc = c & 31, ob = rr * 64 + cc * 2; return st * 1024 + (ob ^ (((ob >> 9) & 1) << 5)); }
__host__ __device__ __forceinline__ void stage_rc(int b, int& R, int& C) { const int st = b / 1024, sb = b % 1024, swz = sb ^ (((sb >> 9) & 1) << 5); R = (st >> 1) * 16 + swz / 64; C = (st & 1) * 32 + (swz % 64) / 2; }
__host__ __device__ __forceinline__ int perm32(int rho) { const int n = rho >> 4, i = rho & 15; return 8 * (i >> 2) + 4 * n + (i & 3); }

struct Unit { int pm, pn; };
struct Gemm { const bf16_t* A; const bf16_t* Bt; int M, N, K; size_t axs; };

struct StaticOrder {
    int nM, nN, nwg, G, c;
    __host__ __device__ void init(int M_, int N_, int G_, int c_) { nM = M_ / BM; nN = N_ / BM; nwg = nM * nN; G = G_; c = c_; }
    __host__ __device__ bool next(int i, Unit& u) const {
        const long L = (long)i * G + c; if (L >= nwg) return false;
        int wgid = (int)L; { const int q = nwg / NXCD, r = nwg % NXCD, xcd = wgid % NXCD, off = wgid / NXCD; wgid = (xcd < r ? xcd * (q + 1) : r * (q + 1) + (xcd - r) * q) + off; }
        const int nig = WGM * nN, gid = wgid / nig, fm = gid * WGM, gsz = (nM - fm) < WGM ? (nM - fm) : WGM;
        u.pm = fm + ((wgid % nig) % gsz); u.pn = (wgid % nig) / gsz; return true;
    }
    __device__ __forceinline__ void a_ready(const Unit&) const {}
    __device__ __forceinline__ void done(const Unit&) const {}
};

constexpr int RSL_OFF = 131072 + 1024;
template <class Sched, bool SYNC = true> __device__ __forceinline__ void fill_rs(LAS unsigned char* lds, const Sched& S, const unsigned char* ws) {
    int tid_ = threadIdx.x; asm volatile("" : "+v"(tid_));
    const float* ssqp = (const float*)(ws + WS_SSQ); LAS float* rsl = (LAS float*)(lds + RSL_OFF);
    const int half = tid_ >> 8, r = tid_ & 255;
    Unit u;
    for (int i = half; S.next(i, u); i += 2) {
        const f32x4* sp = (const f32x4*)(ssqp + (unsigned)(u.pm * BM + r) * 16);
        const f32x4 s4 = (sp[0] + sp[1]) + (sp[2] + sp[3]);
        rsl[i * 256 + r] = __builtin_amdgcn_rsqf(((s4[0] + s4[1]) + (s4[2] + s4[3])) * (1.0f / D) + RMS_EPS);
    }
    if (SYNC) __syncthreads();
}
struct NoPre { template <class Sched> __device__ __forceinline__ void operator()(LAS unsigned char*, const Sched&) const {} };
struct RsPre { const unsigned char* ws; template <class Sched> __device__ __forceinline__ void operator()(LAS unsigned char* lds, const Sched& S) const { fill_rs<Sched, false>(lds, S, ws); } };
template <int N> __device__ __forceinline__ void wait_vm() { asm volatile("s_waitcnt vmcnt(%0)" :: "n"(N) : "memory"); }
template <int ACT> struct EpiProj {
    static constexpr bool PERM = true, AFTER_DRAIN = false; static constexpr int NST = 16;
    bf16_t* O; int ldc;
    __device__ __forceinline__ void operator()(const f32x4 (&acc)[2][2][4][2], const Unit& u, int ui, LAS unsigned char* lds, int wr, int wc, int fr, int fq) const {
        const LAS float* rsl = (const LAS float*)(lds + RSL_OFF) + ui * 256 + wr * 64 + fr;
        const int row0 = (u.pm & 15) * BM + wr * 64 + fr, col0 = u.pn * BM + wc * 32 + 8 * fq; bf16_t* Os = O + (size_t)(u.pm >> 4) * (XS / 2);
#pragma unroll
        for (int ai = 0; ai < 2; ++ai)
#pragma unroll
            for (int m = 0; m < 4; ++m) {
                const int row = row0 + ai * HALF + m * 16; const float rs = rsl[ai * HALF + m * 16];
                bf16_t* rowp = Os + (size_t)row * ldc + col0;
                if (ACT == 0 && u.pn >= 5) {
                    const int cw = wc * 32 + 8 * fq; f32x4 v0, v1;
                    if (u.pn < 8) { const float r2 = rs * rs; v0 = acc[ai][0][m][0] * acc[ai][1][m][0] * r2; v1 = acc[ai][0][m][1] * acc[ai][1][m][1] * r2; }
                    else { v0 = acc[ai][0][m][0] * rs; v1 = acc[ai][0][m][1] * rs; }
                    u32x4 w; w.x = cvt_pk_bf16(v0[0], v0[1]); w.y = cvt_pk_bf16(v0[2], v0[3]); w.z = cvt_pk_bf16(v1[0], v1[1]); w.w = cvt_pk_bf16(v1[2], v1[3]);
                    *(u32x4*)(Os + (size_t)row * ldc + (u.pn < 8 ? OFF_H + 128 * (u.pn - 5) : OFF_ZC1) + cw) = w;
                    continue;
                }
#pragma unroll
                for (int bj = 0; bj < 2; ++bj) {
                    f32x4 v0 = acc[ai][bj][m][0] * rs, v1 = acc[ai][bj][m][1] * rs;
                    if (ACT == 1) {
#pragma unroll
                        for (int j = 0; j < 4; ++j) { const float a = fmaxf(v0[j], 0.f), b = fmaxf(v1[j], 0.f); v0[j] = a * a; v1[j] = b * b; }
                    }
                    u32x4 w; w.x = cvt_pk_bf16(v0[0], v0[1]); w.y = cvt_pk_bf16(v0[2], v0[3]); w.z = cvt_pk_bf16(v1[0], v1[1]); w.w = cvt_pk_bf16(v1[2], v1[3]);
                    *(u32x4*)(rowp + bj * HALF) = w;
                }
            }
    }
};
struct EpiGate {
    static constexpr bool PERM = true, AFTER_DRAIN = false; static constexpr int NST = 16;
    unsigned char* ws;
    __device__ __forceinline__ void operator()(const f32x4 (&acc)[2][2][4][2], const Unit& u, int ui, LAS unsigned char* lds, int wr, int wc, int fr, int fq) const {
        const LAS float* rsl = (const LAS float*)(lds + RSL_OFF) + ui * 256 + wr * 64 + fr; bf16_t* gate = (bf16_t*)(ws + WS_R1 + (size_t)(u.pm >> 4) * XS + SL_GATE);
        const int row0 = (u.pm & 15) * BM + wr * 64 + fr, col0 = u.pn * BM + wc * 32 + 8 * fq;
#pragma unroll
        for (int ai = 0; ai < 2; ++ai)
#pragma unroll
            for (int m = 0; m < 4; ++m) {
                const unsigned off = (unsigned)(row0 + ai * HALF + m * 16) * D + col0; const float rs = rsl[ai * HALF + m * 16];
#pragma unroll
                for (int bj = 0; bj < 2; ++bj) {
                    f32x4 v0 = acc[ai][bj][m][0] * rs, v1 = acc[ai][bj][m][1] * rs;
#pragma unroll
                    for (int j = 0; j < 4; ++j) { v0[j] = __builtin_amdgcn_rcpf(1.0f + __builtin_amdgcn_exp2f(-1.44269504089f * v0[j])); v1[j] = __builtin_amdgcn_rcpf(1.0f + __builtin_amdgcn_exp2f(-1.44269504089f * v1[j])); }
                    u32x4 w; w.x = cvt_pk_bf16(v0[0], v0[1]); w.y = cvt_pk_bf16(v0[2], v0[3]); w.z = cvt_pk_bf16(v1[0], v1[1]); w.w = cvt_pk_bf16(v1[2], v1[3]);
                    *(u32x4*)(gate + off + bj * HALF) = w;
                }
            }
    }
};
template <bool GATED> struct EpiRes {
    static constexpr bool PERM = true, AFTER_DRAIN = false; static constexpr int NST = 24;
    unsigned char* ws;
    __device__ __forceinline__ void operator()(const f32x4 (&acc)[2][2][4][2], const Unit& u, int ui, LAS unsigned char* lds, int wr, int wc, int fr, int fq) const {
        bf16_t* xb = (bf16_t*)(ws + WS_XB); float* ssqp = (float*)(ws + WS_SSQ); const bf16_t* gate = (const bf16_t*)(ws + WS_R1 + (size_t)(u.pm >> 4) * XS + SL_GATE) - (size_t)(u.pm >> 4) * 4096 * D;
        const int row0 = u.pm * BM + wr * 64 + fr, col0 = u.pn * BM + wc * 32 + 8 * fq;
#pragma unroll
        for (int ai = 0; ai < 2; ++ai) {
            u32x4 b[4][2], g[4][2];
#pragma unroll
            for (int m = 0; m < 4; ++m) { const unsigned off = (unsigned)(row0 + ai * HALF + m * 16) * D + col0;
#pragma unroll
                for (int bj = 0; bj < 2; ++bj) { const unsigned c = off + bj * HALF; b[m][bj] = *(const u32x4*)(xb + c); if (GATED) g[m][bj] = *(const u32x4*)(gate + c); } }
#pragma unroll
            for (int m = 0; m < 4; ++m) { const int row = row0 + ai * HALF + m * 16; const unsigned off = (unsigned)row * D + col0; float q = 0.f;
#pragma unroll
                for (int bj = 0; bj < 2; ++bj) { const unsigned c = off + bj * HALF; f32x4 a0 = acc[ai][bj][m][0], a1 = acc[ai][bj][m][1];
                    if (GATED) { const u32x4 gg = g[m][bj]; a0[0] *= bf_lo(gg.x); a0[1] *= bf_hi(gg.x); a0[2] *= bf_lo(gg.y); a0[3] *= bf_hi(gg.y); a1[0] *= bf_lo(gg.z); a1[1] *= bf_hi(gg.z); a1[2] *= bf_lo(gg.w); a1[3] *= bf_hi(gg.w); }
                    const u32x4 bb = b[m][bj];
                    const f32x4 o0 = (f32x4){bf_lo(bb.x), bf_hi(bb.x), bf_lo(bb.y), bf_hi(bb.y)} + a0, o1 = (f32x4){bf_lo(bb.z), bf_hi(bb.z), bf_lo(bb.w), bf_hi(bb.w)} + a1;
                    u32x4 w; w.x = cvt_pk_bf16(o0[0], o0[1]); w.y = cvt_pk_bf16(o0[2], o0[3]); w.z = cvt_pk_bf16(o1[0], o1[1]); w.w = cvt_pk_bf16(o1[2], o1[3]); *(u32x4*)(xb + c) = w;
                    q += ((o0[0] * o0[0] + o0[1] * o0[1]) + (o0[2] * o0[2] + o0[3] * o0[3])) + ((o1[0] * o1[0] + o1[1] * o1[1]) + (o1[2] * o1[2] + o1[3] * o1[3])); }
                q += __shfl_xor(q, 16); q += __shfl_xor(q, 32);
                if (fq == 0) ssqp[(unsigned)row * 16 + u.pn * 4 + wc] = q; }
            asm volatile("" ::: "memory");
        }
    }
};

template <class Epi, class Sched, bool ALIGN_EPI = false, bool SP2 = false, class Pre = NoPre>
__device__ __forceinline__ void gemm_phase(LAS unsigned char* lds, const Gemm g, const Sched& S, const Epi& E, const Pre& pre = Pre()) {
    int tid_ = threadIdx.x; asm volatile("" : "+v"(tid_));
    const int tid = tid_, wid = __builtin_amdgcn_readfirstlane(tid >> 6), lane = tid & 63, wr = wid >> 2, wc = wid & 3, fr = lane & 15, fq = lane >> 4;
    int K_ = g.K; asm volatile("" : "+s"(K_));
    const int K = K_, nt = K / BK;
    unsigned voffA[2], voffB[2];
#pragma unroll
    for (int i = 0; i < 2; ++i) { int R, C; stage_rc(tid * 16 + i * 8192, R, C); const int Rb = Epi::PERM ? ((R & ~31) + perm32(R & 31)) : R;
        voffA[i] = (unsigned)(R * K + C) * 2u; voffB[i] = (unsigned)(Rb * K + C) * 2u; }
    const size_t kstep = (size_t)(BK * 2);
    const size_t hstep = (size_t)HALF * K * 2;
    const size_t tstep = 2 * hstep;
    const unsigned ldsw = (unsigned)wid * 1024u;
    const int aoff = lds_byte(wr * 64 + fr, fq * 8), boff = lds_byte(wc * 32 + fr, fq * 8);
#define PG8_SA(b, h) (((b) * 2 + (h)) * HTB)
#define PG8_SB(b, h) ((4 + (b) * 2 + (h)) * HTB)
#define PG8_STAGE(bufoff, gbase, voff) do { _Pragma("unroll") for (int _i = 0; _i < 2; ++_i) \
        __builtin_amdgcn_global_load_lds((const unsigned*)((const char*)(gbase) + (voff)[_i]), (LAS unsigned*)(lds + (bufoff) + ldsw + _i * 8192), 16, 0, 0); } while (0)
#define PG8_LDA(dst, b, h) do { _Pragma("unroll") for (int m = 0; m < 4; ++m) _Pragma("unroll") for (int k = 0; k < 2; ++k) dst[m][k] = *(const LAS bf16x8*)(lds + PG8_SA(b, h) + aoff + m * 2048 + k * 1024); } while (0)
#define PG8_LDB(dst, b, h) do { _Pragma("unroll") for (int n = 0; n < 2; ++n) _Pragma("unroll") for (int k = 0; k < 2; ++k) dst[n][k] = *(const LAS bf16x8*)(lds + PG8_SB(b, h) + boff + n * 2048 + k * 1024); } while (0)
#define PG8_MMA(ai, bj, At, Bt) do { __builtin_amdgcn_s_setprio(1); _Pragma("unroll") for (int m = 0; m < 4; ++m) _Pragma("unroll") for (int n = 0; n < 2; ++n) _Pragma("unroll") for (int k = 0; k < 2; ++k) \
        acc[ai][bj][m][n] = __builtin_amdgcn_mfma_f32_16x16x32_bf16(Bt[n][k], At[m][k], acc[ai][bj][m][n], 0, 0, 0); __builtin_amdgcn_s_setprio(0); } while (0)
#define PG8_WAIT_V(n) asm volatile("s_waitcnt vmcnt(" #n ")" ::: "memory")
#define PG8_WAIT_L(n) asm volatile("s_waitcnt lgkmcnt(" #n ")" ::: "memory")
#define PG8_BAR __builtin_amdgcn_s_barrier()
#define PG8_SCHED __builtin_amdgcn_sched_barrier(0)
    Unit cur, nxt; int ui = 0;
    if (!S.next(0, cur)) return;
    f32x4 acc[2][2][4][2];
#pragma unroll
    for (int a = 0; a < 2; ++a)
#pragma unroll
        for (int b = 0; b < 2; ++b)
#pragma unroll
            for (int m = 0; m < 4; ++m)
#pragma unroll
                for (int n = 0; n < 2; ++n) acc[a][b][m][n] = (f32x4){0.f, 0.f, 0.f, 0.f};
    bf16x8 At[4][2], B0[2][2], B1[2][2];
    const char* cA = (const char*)g.A + (size_t)(cur.pm >> 4) * g.axs + (size_t)(cur.pm & 15) * tstep; const char* cB = (const char*)g.Bt + (size_t)cur.pn * tstep;
    S.a_ready(cur);
    if constexpr (SP2) {
        PG8_STAGE(PG8_SB(0, 0), cB, voffB); PG8_STAGE(PG8_SB(0, 1), cB + hstep, voffB); PG8_STAGE(PG8_SA(0, 0), cA, voffA); PG8_STAGE(PG8_SA(0, 1), cA + hstep, voffA);
        if (wr == 1) PG8_BAR;
        PG8_WAIT_V(2); PG8_BAR;
        PG8_STAGE(PG8_SB(1, 0), cB + kstep, voffB); PG8_STAGE(PG8_SA(1, 0), cA + kstep, voffA); PG8_STAGE(PG8_SB(1, 1), cB + hstep + kstep, voffB);
        pre(lds, S);
        PG8_WAIT_V(6); PG8_BAR;
    } else {
        PG8_STAGE(PG8_SB(0, 0), cB, voffB); PG8_STAGE(PG8_SA(0, 0), cA, voffA); PG8_STAGE(PG8_SB(0, 1), cB + hstep, voffB); PG8_STAGE(PG8_SA(0, 1), cA + hstep, voffA);
        if (wr == 1) PG8_BAR;
        PG8_WAIT_V(4); PG8_BAR;
        PG8_STAGE(PG8_SB(1, 0), cB + kstep, voffB); PG8_STAGE(PG8_SA(1, 0), cA + kstep, voffA); PG8_STAGE(PG8_SB(1, 1), cB + hstep + kstep, voffB);
        PG8_WAIT_V(6); PG8_BAR;
    }
    for (;;) {
        const bool has_next = S.next(ui + 1, nxt);
        const char* nA = has_next ? (const char*)g.A + (size_t)(nxt.pm >> 4) * g.axs + (size_t)(nxt.pm & 15) * tstep : cA; const char* nB = has_next ? (const char*)g.Bt + (size_t)nxt.pn * tstep : cB;
        for (int t = 0; t < nt; t += 2) {
            const bool last = (t == nt - 2);
            const char* a1 = cA + (size_t)(t + 1) * kstep;
            const char* a2 = last ? nA : cA + (size_t)(t + 2) * kstep; const char* b2 = last ? nB : cB + (size_t)(t + 2) * kstep;
            const char* a3 = a2 + kstep; const char* b3 = b2 + kstep;
            if (last && has_next) S.a_ready(nxt);
            if constexpr (SP2) {
            PG8_LDB(B0, 0, 0); PG8_LDB(B1, 0, 1); PG8_SCHED; PG8_LDA(At, 0, 0); PG8_STAGE(PG8_SA(1, 1), a1 + hstep, voffA);
            PG8_WAIT_V(8);
            PG8_WAIT_L(0); PG8_BAR; PG8_MMA(0, 0, At, B0); PG8_MMA(0, 1, At, B1); PG8_BAR; PG8_SCHED;
            PG8_LDA(At, 0, 1); PG8_STAGE(PG8_SB(0, 0), b2, voffB); PG8_STAGE(PG8_SB(0, 1), b2 + hstep, voffB); PG8_STAGE(PG8_SA(0, 0), a2, voffA);
            PG8_WAIT_V(8);
            PG8_WAIT_L(0); PG8_BAR; PG8_MMA(1, 0, At, B0); PG8_MMA(1, 1, At, B1); PG8_BAR; PG8_SCHED;
            PG8_LDB(B0, 1, 0); PG8_LDB(B1, 1, 1); PG8_SCHED; PG8_LDA(At, 1, 0); PG8_STAGE(PG8_SA(0, 1), a2 + hstep, voffA);
            PG8_WAIT_V(8); PG8_WAIT_L(0); PG8_BAR; PG8_MMA(0, 0, At, B0); PG8_MMA(0, 1, At, B1); PG8_BAR; PG8_SCHED;
            PG8_LDA(At, 1, 1); PG8_STAGE(PG8_SB(1, 0), b3, voffB); PG8_STAGE(PG8_SB(1, 1), b3 + hstep, voffB); PG8_STAGE(PG8_SA(1, 0), a3, voffA);
            PG8_WAIT_V(8); PG8_WAIT_L(0); PG8_BAR; PG8_MMA(1, 0, At, B0); PG8_MMA(1, 1, At, B1); PG8_BAR; PG8_SCHED;
            } else {
            PG8_LDB(B0, 0, 0); PG8_SCHED; PG8_LDA(At, 0, 0); PG8_STAGE(PG8_SA(1, 1), a1 + hstep, voffA);
            PG8_WAIT_L(8); PG8_BAR; PG8_WAIT_L(0); PG8_MMA(0, 0, At, B0); PG8_BAR; PG8_SCHED;
            PG8_LDB(B1, 0, 1); PG8_STAGE(PG8_SB(0, 0), b2, voffB);
            PG8_BAR; PG8_WAIT_L(0); PG8_MMA(0, 1, At, B1); PG8_BAR;
            PG8_LDA(At, 0, 1); PG8_STAGE(PG8_SA(0, 0), a2, voffA);
            PG8_BAR; PG8_WAIT_L(0); PG8_MMA(1, 0, At, B0); PG8_BAR; PG8_SCHED;
            PG8_STAGE(PG8_SB(0, 1), b2 + hstep, voffB);
            PG8_WAIT_V(6); PG8_BAR; PG8_MMA(1, 1, At, B1); PG8_BAR;
            PG8_LDB(B0, 1, 0); PG8_SCHED; PG8_LDA(At, 1, 0); PG8_STAGE(PG8_SA(0, 1), a2 + hstep, voffA);
            PG8_WAIT_L(8); PG8_BAR; PG8_WAIT_L(0); PG8_MMA(0, 0, At, B0); PG8_BAR; PG8_SCHED;
            PG8_LDB(B1, 1, 1); PG8_STAGE(PG8_SB(1, 0), b3, voffB);
            PG8_BAR; PG8_WAIT_L(0); PG8_MMA(0, 1, At, B1); PG8_BAR;
            PG8_LDA(At, 1, 1); PG8_STAGE(PG8_SA(1, 0), a3, voffA);
            PG8_BAR; PG8_WAIT_L(0); PG8_MMA(1, 0, At, B0); PG8_BAR; PG8_SCHED;
            PG8_STAGE(PG8_SB(1, 1), b3 + hstep, voffB);
            PG8_WAIT_V(6); PG8_BAR; PG8_MMA(1, 1, At, B1); PG8_BAR;
            }
        }
        if constexpr (ALIGN_EPI) { if (wr == 0) PG8_BAR; }
        E(acc, cur, ui, lds, wr, wc, fr, fq); S.done(cur);
        if (!has_next) break;
#pragma unroll
        for (int a = 0; a < 2; ++a)
#pragma unroll
            for (int b = 0; b < 2; ++b)
#pragma unroll
                for (int m = 0; m < 4; ++m)
#pragma unroll
                    for (int n = 0; n < 2; ++n) acc[a][b][m][n] = (f32x4){0.f, 0.f, 0.f, 0.f};
        cur = nxt; cA = nA; cB = nB; ++ui;
        if constexpr (ALIGN_EPI) { if (wr == 1) PG8_BAR; }
    }
    PG8_WAIT_V(0);
    if constexpr (!ALIGN_EPI) { if (wr == 0) PG8_BAR; }
    PG8_BAR;
#undef PG8_SA
#undef PG8_SB
#undef PG8_STAGE
#undef PG8_LDA
#undef PG8_LDB
#undef PG8_MMA
#undef PG8_WAIT_V
#undef PG8_WAIT_L
#undef PG8_BAR
#undef PG8_SCHED
}
}

__device__ __forceinline__ void unpack8(const u32x4 r, float (&f)[8]) {
    f[0] = bf_lo(r.x); f[1] = bf_hi(r.x); f[2] = bf_lo(r.y); f[3] = bf_hi(r.y); f[4] = bf_lo(r.z); f[5] = bf_hi(r.z); f[6] = bf_lo(r.w); f[7] = bf_hi(r.w);
}
__device__ __forceinline__ u32x4 pack8(const float (&f)[8]) {
    u32x4 w; w.x = cvt_pk_bf16(f[0], f[1]); w.y = cvt_pk_bf16(f[2], f[3]); w.z = cvt_pk_bf16(f[4], f[5]); w.w = cvt_pk_bf16(f[6], f[7]); return w;
}
__device__ __forceinline__ void gelu8(float (&f)[8]) {
#pragma unroll
    for (int j = 0; j < 8; j += 2) { const f32x2 r = gelu_pk((f32x2){f[j], f[j + 1]}); f[j] = r.x; f[j + 1] = r.y; }
}

constexpr int VNT_STRIDE = 272, VNT_BYTES = 64 * VNT_STRIDE;
__device__ __forceinline__ const bf16_t* prow(const unsigned char* ws, int row) { return (const bf16_t*)(ws + slice_off(row) + SL_PROJ) + (size_t)(row & 4095) * PLD; }
template <int GRP>
__device__ __forceinline__ void pool_group(const unsigned char* __restrict__ ws, bf16_t* __restrict__ Yrow, const bf16_t* __restrict__ wpT, int G, int pos, int fr, int fq) {
    constexpr int win = 2 << GRP;
    f32x4 acc[4];
#pragma unroll
    for (int n = 0; n < 4; ++n) acc[n] = (f32x4){0.f, 0.f, 0.f, 0.f};
    const int cnt = (pos + 1) < win ? (pos + 1) : win;
    const float inv = 1.0f / (float)cnt;
#pragma unroll
    for (int ks = 0; ks < 2; ++ks) {
        const int c = GRP * 64 + ks * 32 + 8 * fq;
        constexpr int NB = win < 8 ? win : 8;
        bf16x8 bfr[4];
#pragma unroll
        for (int n = 0; n < 4; ++n) bfr[n] = *(const bf16x8*)(wpT + GRP * 4096 + (32 * (n >> 1) + 8 * (fr >> 2) + 4 * (n & 1) + (fr & 3)) * 64 + ks * 32 + 8 * fq);
        float s[8], z0[8];
#pragma unroll
        for (int j = 0; j < 8; ++j) { s[j] = 0.f; z0[j] = 0.f; }
#pragma unroll
        for (int j0 = 0; j0 < win; j0 += NB) {
            u32x4 r[NB];
#pragma unroll
            for (int jj = 0; jj < NB; ++jj) r[jj] = *(const u32x4*)(prow(ws, G - ((j0 + jj) < cnt ? (j0 + jj) : 0)) + (GRP < 2 ? OFF_ZC0 : OFF_ZC1 - 128) + c);
#pragma unroll
            for (int jj = 0; jj < NB; ++jj) { float v[8]; unpack8(r[jj], v); const float mk = (j0 + jj) < cnt ? 1.f : 0.f;
#pragma unroll
                for (int j = 0; j < 8; ++j) { s[j] += mk * v[j]; if (j0 + jj == 0) z0[j] = v[j]; } }
            if (j0 + NB < win) asm volatile("" ::: "memory");
        }
        float pl[8];
#pragma unroll
        for (int j = 0; j < 8; ++j) pl[j] = s[j] * inv - z0[j];
        const bf16x8 af = __builtin_bit_cast(bf16x8, pack8(pl));
#pragma unroll
        for (int n = 0; n < 4; ++n) acc[n] = __builtin_amdgcn_mfma_f32_16x16x32_bf16(bfr[n], af, acc[n], 0, 0, 0);
    }
    bf16_t* yp = Yrow + 768 + GRP * 64 + 8 * fq;
#pragma unroll
    for (int k = 0; k < 2; ++k) { u32x4 w; w.x = cvt_pk_bf16(acc[2 * k][0], acc[2 * k][1]); w.y = cvt_pk_bf16(acc[2 * k][2], acc[2 * k][3]); w.z = cvt_pk_bf16(acc[2 * k + 1][0], acc[2 * k + 1][1]); w.w = cvt_pk_bf16(acc[2 * k + 1][2], acc[2 * k + 1][3]); *(u32x4*)(yp + 32 * k) = w; }
}
__device__ __forceinline__ void mixer_chunk(LAS unsigned char* lds, int chunk, unsigned char* __restrict__ ws,
                                            const bf16_t* __restrict__ sguw, const float* __restrict__ sgub, const float* __restrict__ lng, const float* __restrict__ lnb,
                                            const float* __restrict__ convw, const bf16_t* __restrict__ wpT) {
    int tid_ = threadIdx.x; asm volatile("" : "+v"(tid_));
    const int tid = tid_, wid = __builtin_amdgcn_readfirstlane(tid >> 6), lane = tid & 63, fr = lane & 15, fq = lane >> 4;
    const int T0 = chunk * 128;
    const bf16_t* __restrict__ Pc = prow(ws, T0);
    bf16_t* __restrict__ Yc = (bf16_t*)(ws + slice_off(T0) + SL_YCAT) + (size_t)(T0 & 4095) * D;
    {
        const int pr = tid >> 3, q = tid & 7;
        const bf16_t* src = Pc + (size_t)(2 * pr) * PLD + OFF_VA + 8 * q;
#pragma unroll 1
        for (int hb = 0; hb < 6; hb += 3) {
        u32x4 r0[3], r1[3];
#pragma unroll
        for (int hh = 0; hh < 3; ++hh) { r0[hh] = *(const u32x4*)(src + (hb + hh) * 64); r1[hh] = *(const u32x4*)(src + PLD + (hb + hh) * 64); }
#pragma unroll
        for (int hh = 0; hh < 3; ++hh) { const int h = hb + hh;
            LAS unsigned char* buf = lds + h * VNT_BYTES;
            float a[8], b[8]; unpack8(r0[hh], a); unpack8(r1[hh], b); gelu8(a); gelu8(b);
            float s0 = 0.f, s1 = 0.f;
#pragma unroll
            for (int j = 0; j < 8; ++j) { s0 += a[j]; s1 += b[j]; }
            s0 += __shfl_xor(s0, 1); s1 += __shfl_xor(s1, 1); s0 += __shfl_xor(s0, 2); s1 += __shfl_xor(s1, 2); s0 += __shfl_xor(s0, 4); s1 += __shfl_xor(s1, 4);
            const float m0 = s0 * (1.f / 64.f), m1 = s1 * (1.f / 64.f);
            float q0 = 0.f, q1 = 0.f;
#pragma unroll
            for (int j = 0; j < 8; ++j) { a[j] -= m0; b[j] -= m1; q0 += a[j] * a[j]; q1 += b[j] * b[j]; }
            q0 += __shfl_xor(q0, 1); q1 += __shfl_xor(q1, 1); q0 += __shfl_xor(q0, 2); q1 += __shfl_xor(q1, 2); q0 += __shfl_xor(q0, 4); q1 += __shfl_xor(q1, 4);
            const float rs0 = __builtin_amdgcn_rsqf(q0 * (1.f / 64.f) + LN_EPS), rs1 = __builtin_amdgcn_rsqf(q1 * (1.f / 64.f) + LN_EPS);
            const f32x4 g0 = *(const f32x4*)(lng + h * 64 + 8 * q), g1 = *(const f32x4*)(lng + h * 64 + 8 * q + 4);
            const f32x4 c0 = *(const f32x4*)(lnb + h * 64 + 8 * q), c1 = *(const f32x4*)(lnb + h * 64 + 8 * q + 4);
#pragma unroll
            for (int j = 0; j < 8; ++j) {
                const float gg = j < 4 ? g0[j & 3] : g1[j & 3], cc = j < 4 ? c0[j & 3] : c1[j & 3];
                const unsigned w = cvt_pk_bf16(a[j] * rs0 * gg + cc, b[j] * rs1 * gg + cc);
                *(LAS unsigned*)(buf + (8 * q + j) * VNT_STRIDE + pr * 4) = w;
            }
        }
        }
    }
    if (tid < 384) {
        const int strip = tid / 48, grp = tid % 48, ch = grp * 8;
        float w0[8], w1[8], w2[8], hm2[8], hm1[8];
        { const f32x4 a0 = *(const f32x4*)(convw + ch), a1 = *(const f32x4*)(convw + ch + 4), b0 = *(const f32x4*)(convw + 384 + ch), b1 = *(const f32x4*)(convw + 384 + ch + 4),
                      c0 = *(const f32x4*)(convw + 768 + ch), c1 = *(const f32x4*)(convw + 768 + ch + 4);
#pragma unroll
          for (int j = 0; j < 4; ++j) { w0[j] = a0[j]; w0[j + 4] = a1[j]; w1[j] = b0[j]; w1[j + 4] = b1[j]; w2[j] = c0[j]; w2[j + 4] = c1[j]; } }
        const int tg0 = T0 + strip * 16, tl0 = strip * 16;
        {
            const bool first = (tg0 & (SEQ - 1)) == 0;
            const bf16_t* pz = prow(ws, first ? tg0 : tg0 - 2) + ch;
            float z[8]; const float mk = first ? 0.f : 1.f;
            unpack8(*(const u32x4*)(pz + OFF_H), z);
#pragma unroll
            for (int j = 0; j < 8; ++j) hm2[j] = mk * z[j];
            unpack8(*(const u32x4*)(pz + PLD + OFF_H), z);
#pragma unroll
            for (int j = 0; j < 8; ++j) hm1[j] = mk * z[j];
        }
#pragma unroll 1
        for (int i0 = 0; i0 < 16; i0 += 4) {
            u32x4 rz[4], rg[4];
#pragma unroll
            for (int k = 0; k < 4; ++k) { const bf16_t* pz = Pc + (size_t)(tl0 + i0 + k) * PLD + ch; rz[k] = *(const u32x4*)(pz + OFF_H); rg[k] = *(const u32x4*)(pz + OFF_GB); }
#pragma unroll
            for (int k = 0; k < 4; ++k) {
                float z[8], gbv[8], o[8];
                unpack8(rz[k], z); unpack8(rg[k], gbv);
#pragma unroll
                for (int j = 0; j < 8; ++j) { const float hh = z[j]; o[j] = gbv[j] * (w0[j] * hm2[j] + w1[j] * hm1[j] + w2[j] * hh); hm2[j] = hm1[j]; hm1[j] = hh; }
                *(u32x4*)(Yc + (size_t)(tl0 + i0 + k) * D + 384 + ch) = pack8(o);
            }
        }
    }
    __syncthreads();
    {
        const int t0 = 16 * wid, nks = (wid >> 1) + 1, t = t0 + fr;
        const bf16_t* up = Pc + (size_t)t * PLD + OFF_UA + 8 * fq;
        bf16_t* yp = Yc + (size_t)t * D + 8 * fq;
#pragma unroll 2
        for (int h = 0; h < 6; ++h) {
            const LAS unsigned char* buf = lds + h * VNT_BYTES;
            u32x4 uu[2];
#pragma unroll
            for (int k = 0; k < 2; ++k) uu[k] = *(const u32x4*)(up + h * 64 + 32 * k);
            const float bs = sgub[h * 128 + t];
            f32x4 acc[4];
#pragma unroll
            for (int n = 0; n < 4; ++n) acc[n] = (f32x4){0.f, 0.f, 0.f, 0.f};
            const bf16_t* Wr = sguw + h * 16384 + (t0 + fr) * 128 + 8 * fq;
            for (int ks = 0; ks < nks; ++ks) {
                const bf16x8 af = *(const bf16x8*)(Wr + ks * 32);
#pragma unroll
                for (int n = 0; n < 4; ++n) {
                    const bf16x8 bfr = *(const LAS bf16x8*)(buf + (32 * (n >> 1) + 8 * (fr >> 2) + 4 * (n & 1) + (fr & 3)) * VNT_STRIDE + (ks * 32 + 8 * fq) * 2);
                    acc[n] = __builtin_amdgcn_mfma_f32_16x16x32_bf16(bfr, af, acc[n], 0, 0, 0);
                }
            }
#pragma unroll
            for (int k = 0; k < 2; ++k) {
                const f32x2 ga = gelu_pk((f32x2){bf_lo(uu[k].x), bf_hi(uu[k].x)}), gb = gelu_pk((f32x2){bf_lo(uu[k].y), bf_hi(uu[k].y)});
                const f32x2 gc = gelu_pk((f32x2){bf_lo(uu[k].z), bf_hi(uu[k].z)}), gd = gelu_pk((f32x2){bf_lo(uu[k].w), bf_hi(uu[k].w)});
                u32x4 w; w.x = cvt_pk_bf16(ga.x * (acc[2 * k][0] + bs), ga.y * (acc[2 * k][1] + bs)); w.y = cvt_pk_bf16(gb.x * (acc[2 * k][2] + bs), gb.y * (acc[2 * k][3] + bs));
                w.z = cvt_pk_bf16(gc.x * (acc[2 * k + 1][0] + bs), gc.y * (acc[2 * k + 1][1] + bs)); w.w = cvt_pk_bf16(gd.x * (acc[2 * k + 1][2] + bs), gd.y * (acc[2 * k + 1][3] + bs));
                *(u32x4*)(yp + h * 64 + 32 * k) = w;
            }
        }
    }
    {
        const int G = T0 + 16 * wid + fr, pos = G & (SEQ - 1);
        bf16_t* Yrow = Yc + (size_t)(16 * wid + fr) * D;
        pool_group<0>(ws, Yrow, wpT, G, pos, fr, fq); pool_group<1>(ws, Yrow, wpT, G, pos, fr, fq); pool_group<2>(ws, Yrow, wpT, G, pos, fr, fq); pool_group<3>(ws, Yrow, wpT, G, pos, fr, fq);
    }
    __syncthreads();
}

__device__ __forceinline__ float wave_sum(float v) {
#pragma unroll
    for (int o = 1; o < 64; o <<= 1) v += __shfl_xor(v, o);
    return v;
}
template <bool INPROJ = false>
__device__ __forceinline__ void transpose_item(const float* __restrict__ W, const float* __restrict__ gain, int K, int N, bf16_t* __restrict__ WT, LAS float* scr, int item, int lane) {
    const int nblk = N / 32, kb = item / nblk, nb = item % nblk, k0 = 64 * kb, n0 = 32 * nb, n0d = INPROJ ? inproj_row(n0) : n0;
#pragma unroll
    for (int i = 0; i < 32; ++i) { const int kk = 2 * i + (lane >> 5); const float gsc = gain ? gain[k0 + kk] : 1.0f; scr[kk * 33 + (lane & 31)] = W[(size_t)(k0 + kk) * N + n0 + (lane & 31)] * gsc; }
    asm volatile("s_waitcnt lgkmcnt(0)" ::: "memory");
    const int c = lane & 7;
#pragma unroll
    for (int j = 0; j < 4; ++j) { const int n = (lane >> 3) + 8 * j; const LAS float* s = scr + (8 * c) * 33 + n;
        u32x4 o; o.x = cvt_pk_bf16(s[0 * 33], s[1 * 33]); o.y = cvt_pk_bf16(s[2 * 33], s[3 * 33]); o.z = cvt_pk_bf16(s[4 * 33], s[5 * 33]); o.w = cvt_pk_bf16(s[6 * 33], s[7 * 33]);
        *(u32x4*)(WT + (size_t)(n0d + n) * K + k0 + 8 * c) = o; }
    asm volatile("s_waitcnt lgkmcnt(0)" ::: "memory");
}


#define XB_TMO      128
#define XB_XCNT(j)  (256  + 64 * (j))
#define XB_XSUB(j)  (1280 + 64 * (j))
#define XB_XGEN(j)  (2304 + 64 * (j))
#define XB_TOP      3328
#define XB_TOPGEN   3392
#define XCD_BAR_WORDS 3456
#define XB_SPIN_CAP (1u << 22)
__device__ __forceinline__ unsigned xb_ld(unsigned* p)              { return __hip_atomic_load(p, __ATOMIC_RELAXED, __HIP_MEMORY_SCOPE_AGENT); }
__device__ __forceinline__ unsigned xb_add(unsigned* p, unsigned v) { return __hip_atomic_fetch_add(p, v, __ATOMIC_RELAXED, __HIP_MEMORY_SCOPE_AGENT); }
__device__ __forceinline__ unsigned xb_xcc_id() { return (unsigned)__builtin_amdgcn_s_getreg((3 << 11) | 20) & 0xFu; }
#define XB_SPIN(cond, bar) do { unsigned _sp = 0; while (cond) { __builtin_amdgcn_s_sleep(1); \
    if ((++_sp & 255u) == 0u) { if (xb_ld(&(bar)[XB_TMO])) break; if (_sp > XB_SPIN_CAP) { atomicAdd(&(bar)[XB_TMO], 1u); break; } } } } while (0)
struct XcdBarrier { unsigned* bar; unsigned x; volatile LAS unsigned* st; };
__device__ __forceinline__ XcdBarrier xcd_barrier_post(unsigned* bar, volatile LAS unsigned* st) {
    XcdBarrier b; b.bar = bar; b.x = xb_xcc_id(); b.st = st;
    if (threadIdx.x == 0) st[2] = xb_add(&bar[XB_XCNT(b.x)], 1u);
    return b;
}
__device__ __forceinline__ void xcd_barrier_complete(unsigned* bar, unsigned x, unsigned& nloc, unsigned& nx) {
    const unsigned G = gridDim.x * gridDim.y * gridDim.z;
    unsigned sum, cnt, mine, sp = 0u;
    for (;;) {
        sum = 0u; cnt = 0u; mine = 0u;
#pragma unroll
        for (unsigned j = 0; j < 16; ++j) { const unsigned c = xb_ld(&bar[XB_XCNT(j)]); sum += c; cnt += (c > 0u) ? 1u : 0u; mine = (j == x) ? c : mine; }
        if (sum == G) break;
        __builtin_amdgcn_s_sleep(1);
        if ((++sp & 255u) == 0u) { if (xb_ld(&bar[XB_TMO])) break; if (sp > XB_SPIN_CAP) { atomicAdd(&bar[XB_TMO], 1u); break; } }
    }
    nloc = mine > 0u ? mine : 1u; nx = cnt > 0u ? cnt : 1u;
}
__device__ __forceinline__ void xcd_barrier(const XcdBarrier& b, bool local = false) {
    asm volatile("s_waitcnt vmcnt(0)" ::: "memory");
    __syncthreads();
    if (threadIdx.x == 0) {
        unsigned* bar = b.bar;
        __builtin_amdgcn_s_waitcnt(0);
        unsigned nloc = b.st[0], nx = b.st[1];
        if (nloc == 0u) { xcd_barrier_complete(bar, b.x, nloc, nx); b.st[0] = nloc; b.st[1] = nx; }
        const unsigned old = xb_add(&bar[XB_XSUB(b.x)], 1u);
        const unsigned gen = old / nloc;
        if (local) {
            if (old + 1u == (gen + 1u) * nloc) xb_add(&bar[XB_XGEN(b.x)], 1u);
            else XB_SPIN(xb_ld(&bar[XB_XGEN(b.x)]) == gen, bar);
            __builtin_amdgcn_fence(__ATOMIC_ACQUIRE, "agent");
            asm volatile("s_waitcnt vmcnt(0)" ::: "memory");
        } else if (old + 1u == (gen + 1u) * nloc) {
            __builtin_amdgcn_fence(__ATOMIC_RELEASE, "agent");
            asm volatile("s_waitcnt vmcnt(0)" ::: "memory");
            const unsigned og = xb_add(&bar[XB_TOP], 1u);
            const unsigned tg = og / nx;
            if (og + 1u == (tg + 1u) * nx) xb_add(&bar[XB_TOPGEN], 1u);
            else XB_SPIN(xb_ld(&bar[XB_TOPGEN]) == tg, bar);
            __builtin_amdgcn_fence(__ATOMIC_ACQUIRE, "agent");
            xb_add(&bar[XB_XGEN(b.x)], 1u);
            asm volatile("s_waitcnt vmcnt(0)" ::: "memory");
        } else {
            XB_SPIN(xb_ld(&bar[XB_XGEN(b.x)]) == gen, bar);
            __builtin_amdgcn_fence(__ATOMIC_ACQUIRE, "agent");
            asm volatile("s_waitcnt vmcnt(0)" ::: "memory");
        }
    }
    __syncthreads();
}

struct Args { const float* in[19]; float* out; unsigned char* ws; };

struct TItem { const float* W; const float* gain; bf16_t* WT; int K, N, k0, n0, n0d; };
__device__ __forceinline__ bool titem_decode(const Args& a, int it, TItem& t) {
    constexpr int I_IN = 16 * (DIN / 32), I_OUT = 16 * 32, I_FF1 = 16 * (FF / 32), I_FF2 = 64 * 32, I_G = 16 * 32, I_P = 4 * 32, I_L = I_IN + I_OUT + I_FF1 + I_FF2 + I_G + I_P;
    if (it >= DEPTH * I_L) return false;
    const int l = it / I_L; int r = it % I_L; unsigned char* wl = a.ws + WS_W + (size_t)l * LW; bool inproj = false;
    if (r < I_IN) { t.W = a.in[3] + (size_t)l * D * DIN; t.gain = a.in[2] + l * D; t.K = D; t.N = DIN; t.WT = (bf16_t*)(wl + LW_IN); inproj = true; }
    else if ((r -= I_IN) < I_OUT) { t.W = a.in[11] + (size_t)l * D * D; t.gain = nullptr; t.K = D; t.N = D; t.WT = (bf16_t*)(wl + LW_OUT); }
    else if ((r -= I_OUT) < I_FF1) { t.W = a.in[13] + (size_t)l * D * FF; t.gain = a.in[12] + l * D; t.K = D; t.N = FF; t.WT = (bf16_t*)(wl + LW_FF1); }
    else if ((r -= I_FF1) < I_FF2) { t.W = a.in[14] + (size_t)l * FF * D; t.gain = nullptr; t.K = FF; t.N = D; t.WT = (bf16_t*)(wl + LW_FF2); }
    else if ((r -= I_FF2) < I_G) { t.W = a.in[16] + (size_t)l * D * D; t.gain = a.in[15] + l * D; t.K = D; t.N = D; t.WT = (bf16_t*)(wl + LW_G); }
    else { r -= I_G; t.W = a.in[17] + (size_t)l * DPLE * D; t.gain = nullptr; t.K = DPLE; t.N = D; t.WT = (bf16_t*)(wl + LW_P); }
    const int nblk = t.N / 32, kb = r / nblk, nb = r % nblk; t.k0 = 64 * kb; t.n0 = 32 * nb; t.n0d = inproj ? inproj_row(t.n0) : t.n0;
    return true;
}
__device__ __forceinline__ void titem_load(const TItem& t, int lane, float (&v)[32]) {
#pragma unroll
    for (int i = 0; i < 32; ++i) { const int kk = 2 * i + (lane >> 5); const float gsc = t.gain ? t.gain[t.k0 + kk] : 1.0f; v[i] = t.W[(size_t)(t.k0 + kk) * t.N + t.n0 + (lane & 31)] * gsc; }
}
__device__ __forceinline__ void titem_store(const TItem& t, int lane, const float (&v)[32], LAS float* scr) {
#pragma unroll
    for (int i = 0; i < 32; ++i) scr[(2 * i + (lane >> 5)) * 33 + (lane & 31)] = v[i];
    asm volatile("s_waitcnt lgkmcnt(0)" ::: "memory");
    const int c = lane & 7;
#pragma unroll
    for (int j = 0; j < 4; ++j) { const int n = (lane >> 3) + 8 * j; const LAS float* sp = scr + (8 * c) * 33 + n;
        u32x4 o; o.x = cvt_pk_bf16(sp[0 * 33], sp[1 * 33]); o.y = cvt_pk_bf16(sp[2 * 33], sp[3 * 33]); o.z = cvt_pk_bf16(sp[4 * 33], sp[5 * 33]); o.w = cvt_pk_bf16(sp[6 * 33], sp[7 * 33]);
        *(u32x4*)(t.WT + (size_t)(t.n0d + n) * t.K + t.k0 + 8 * c) = o; }
    asm volatile("s_waitcnt lgkmcnt(0)" ::: "memory");
}


__device__ __forceinline__ void prologue(const Args& a, LAS unsigned char* lds) {
    const int tid = threadIdx.x, wave = __builtin_amdgcn_readfirstlane(tid >> 6), lane = tid & 63;
    const int G = gridDim.x, gw = blockIdx.x * 8 + wave, NGW = G * 8;
    const size_t gt = (size_t)blockIdx.x * 512 + tid, NT = (size_t)G * 512;
    unsigned char* ws = a.ws;
    LAS float* scr = (LAS float*)(lds + wave * 16384);
    {
        TItem cur, nxt; float vc[32], vn[32];
        if (titem_decode(a, gw, cur)) {
            titem_load(cur, lane, vc);
            for (int it = gw + NGW;; it += NGW) {
                const bool more = titem_decode(a, it, nxt);
                if (more) titem_load(nxt, lane, vn);
                titem_store(cur, lane, vc, scr);
                if (!more) break;
                cur = nxt;
#pragma unroll
                for (int i = 0; i < 32; ++i) vc[i] = vn[i];
            }
        }
    }
    for (size_t i = gt; i < (size_t)DEPTH * 16384; i += NT) { const int l = (int)(i >> 14); const size_t j = i & 16383;
        *(u32x4*)(ws + WS_W + (size_t)l * LW + LW_IN + (size_t)DIN * D * 2 + j * 16) = (u32x4){0u, 0u, 0u, 0u}; }
    for (size_t i = gt; i < (size_t)DEPTH * 6 * 16384; i += NT) { const int l = (int)(i / (6 * 16384)); const int r = (int)(i % (6 * 16384)); const int t = (r >> 7) & 127, s = r & 127;
        const float v = s <= t ? a.in[4][i] : 0.f; ((bf16_t*)(ws + WS_W + (size_t)l * LW + LW_SGU))[r] = (bf16_t)(cvt_pk_bf16(v, 0.f) & 0xffffu); }
    for (size_t i = gt; i < (size_t)DEPTH * 16384; i += NT) { const int l = (int)(i >> 14), r = (int)(i & 16383), g = r >> 12, d = (r >> 6) & 63, c = r & 63;
        const float v = a.in[9][(size_t)l * 16384 + g * 4096 + c * 64 + d] * a.in[10][l * 256 + g * 64 + d];
        ((bf16_t*)(ws + WS_W + (size_t)l * LW + LW_POOL))[r] = (bf16_t)(cvt_pk_bf16(v, 0.f) & 0xffffu); }
    for (size_t i = gt; i < 4 * 768; i += NT) ((float*)(ws + WS_SM_SGUB))[i] = a.in[5][i];
    for (size_t i = gt; i < 4 * 384; i += NT) { ((float*)(ws + WS_SM_LNG))[i] = a.in[6][i]; ((float*)(ws + WS_SM_LNB))[i] = a.in[7][i]; }
    for (size_t i = gt; i < 4 * 1152; i += NT) ((float*)(ws + WS_SM_CONV))[i] = a.in[8][i];
    for (size_t i = gt; i < 1024; i += NT) ((float*)(ws + WS_SM_FG))[i] = a.in[18][i];
    { const f32x4* src = (const f32x4*)a.in[1]; u32x4* dst = (u32x4*)(ws + WS_PB);
      constexpr size_t NIT = (size_t)DEPTH * M * DPLE / 8;
      for (size_t i = gt; i < NIT; i += 4 * NT) { f32x4 v0[4], v1[4];
#pragma unroll
          for (int k = 0; k < 4; ++k) { const size_t ii = i + k * NT < NIT ? i + k * NT : i; v0[k] = src[2 * ii]; v1[k] = src[2 * ii + 1]; }
#pragma unroll
          for (int k = 0; k < 4; ++k) { if (i + k * NT < NIT) { u32x4 w; w.x = cvt_pk_bf16(v0[k][0], v0[k][1]); w.y = cvt_pk_bf16(v0[k][2], v0[k][3]); w.z = cvt_pk_bf16(v1[k][0], v1[k][1]); w.w = cvt_pk_bf16(v1[k][2], v1[k][3]); dst[i + k * NT] = w; } } } }
    { bf16_t* xb = (bf16_t*)(ws + WS_XB); float* ssqp = (float*)(ws + WS_SSQ);
      for (int m0 = gw; m0 < M; m0 += 2 * NGW) {
          f32x4 v[2][4];
#pragma unroll
          for (int r = 0; r < 2; ++r) { const f32x4* xr = (const f32x4*)(a.in[0] + (size_t)(m0 + r * NGW) * D) + lane;
#pragma unroll
              for (int j = 0; j < 4; ++j) v[r][j] = xr[64 * j]; }
#pragma unroll
          for (int r = 0; r < 2; ++r) { const int m = m0 + r * NGW; float s = 0.f; u32x2* o8 = (u32x2*)(xb + (size_t)m * D) + lane;
#pragma unroll
              for (int j = 0; j < 4; ++j) { const f32x4 q = v[r][j]; s += (q[0] * q[0] + q[1] * q[1]) + (q[2] * q[2] + q[3] * q[3]); u32x2 w; w.x = cvt_pk_bf16(q[0], q[1]); w.y = cvt_pk_bf16(q[2], q[3]); o8[64 * j] = w; }
              s = wave_sum(s);
              if (lane < 16) ssqp[(size_t)m * 16 + lane] = lane == 0 ? s : 0.f; } } }
}

__device__ __forceinline__ void final_norm(const Args& a, bool fast, int cid) {
    int tid_ = threadIdx.x; asm volatile("" : "+v"(tid_));
    const int tid = tid_, wave = __builtin_amdgcn_readfirstlane(tid >> 6), lane = tid & 63;
    const int per = M / (int)gridDim.x, NGW = fast ? 8 : (int)gridDim.x * 8, gw = fast ? wave : (int)blockIdx.x * 8 + wave;
    const int mbase = fast ? ((cid & 7) * ((int)gridDim.x / 8) + (cid >> 3)) * per : 0, mend = fast ? mbase + per : M;
    const float* ssqp = (const float*)(a.ws + WS_SSQ); const bf16_t* xb = (const bf16_t*)(a.ws + WS_XB);
    f32x4 gv[2][2];
#pragma unroll
    for (int j = 0; j < 2; ++j) { gv[j][0] = ((const f32x4*)(a.ws + WS_SM_FG))[2 * (lane + 64 * j)]; gv[j][1] = ((const f32x4*)(a.ws + WS_SM_FG))[2 * (lane + 64 * j) + 1]; }
    int m = mbase + gw;
    if (m < mend) {
        u32x4 vc[2], vn[2]; f32x4 sc[4], sn[4];
        { const u32x4* xr = (const u32x4*)(xb + (size_t)m * D); const f32x4* sp = (const f32x4*)(ssqp + (size_t)m * 16);
          vc[0] = xr[lane]; vc[1] = xr[lane + 64]; sc[0] = sp[0]; sc[1] = sp[1]; sc[2] = sp[2]; sc[3] = sp[3]; }
        for (;;) {
            const int m2 = m + NGW; const bool more = m2 < mend;
            if (more) { const u32x4* xr = (const u32x4*)(xb + (size_t)m2 * D); const f32x4* sp = (const f32x4*)(ssqp + (size_t)m2 * 16);
                vn[0] = xr[lane]; vn[1] = xr[lane + 64]; sn[0] = sp[0]; sn[1] = sp[1]; sn[2] = sp[2]; sn[3] = sp[3]; }
            const f32x4 s4 = (sc[0] + sc[1]) + (sc[2] + sc[3]);
            const float rs = __builtin_amdgcn_rsqf(((s4[0] + s4[1]) + (s4[2] + s4[3])) * (1.0f / D) + RMS_EPS);
            f32x4* orow = (f32x4*)(a.out + (size_t)m * D);
#pragma unroll
            for (int j = 0; j < 2; ++j) { const u32x4 v = vc[j];
                orow[2 * (lane + 64 * j)] = (f32x4){bf_lo(v.x), bf_hi(v.x), bf_lo(v.y), bf_hi(v.y)} * rs * gv[j][0];
                orow[2 * (lane + 64 * j) + 1] = (f32x4){bf_lo(v.z), bf_hi(v.z), bf_lo(v.w), bf_hi(v.w)} * rs * gv[j][1]; }
            if (!more) break;
            m = m2; vc[0] = vn[0]; vc[1] = vn[1]; sc[0] = sn[0]; sc[1] = sn[1]; sc[2] = sn[2]; sc[3] = sn[3];
        }
    }
}

__global__ void __launch_bounds__(512, 2) fwd_megakernel(Args a) {
    extern __shared__ __attribute__((aligned(16))) unsigned char lds_raw[];
    LAS unsigned char* lds = (LAS unsigned char*)lds_raw;
    cg::grid_group grid = cg::this_grid();
    const int G = gridDim.x;
#define BARRIER(local_) do { XcdBarrier b_; { size_t z_ = 0; asm volatile("" : "+s"(z_)); b_.bar = (unsigned*)(a.ws + z_) + 4096; } b_.x = xb_xcc_id(); b_.st = (volatile LAS unsigned*)(lds + 131072 + 320) + 8; xcd_barrier(b_, (local_)); } while (0)
#define GRID_SYNC() BARRIER(false)
#define XCD_SYNC() BARRIER(fast)
#define PTRS() size_t z_ = 0; asm volatile("" : "+s"(z_)); unsigned char* ws = a.ws + z_;     \
    int l = l_; asm volatile("" : "+s"(l)); unsigned char* wl = ws + WS_W + (size_t)l * LW; bf16_t* xb = (bf16_t*)(ws + WS_XB); (void)wl; (void)xb;

#ifndef PH
#define PH 0xffff
#endif
    volatile LAS unsigned* MISC = (volatile LAS unsigned*)(lds + 131072 + 320);
    if (threadIdx.x < 32) MISC[threadIdx.x] = 0u;
    __syncthreads();
    if (blockIdx.x == 0) for (int i = threadIdx.x; i < XCD_BAR_WORDS; i += 512) __hip_atomic_store((unsigned*)(a.ws) + 4096 + i, 0u, __ATOMIC_RELAXED, __HIP_MEMORY_SCOPE_AGENT);
    asm volatile("s_waitcnt vmcnt(0)" ::: "memory");
    grid.sync();
    asm volatile("s_waitcnt vmcnt(0)" ::: "memory");
    (void)xcd_barrier_post((unsigned*)(a.ws) + 4096, MISC + 8);
#if PH & 1
    prologue(a, lds);
#endif
    GRID_SYNC();
    bool fast; int cid;
    {
        unsigned* bar = (unsigned*)(a.ws) + 4096; bool ok = (G % 8 == 0) && (G / 8) * 8 == G;
#pragma unroll
        for (int j = 0; j < 16; ++j) { const unsigned cj = xb_ld(&bar[XB_XCNT(j)]); ok = ok && (cj == (j < 8 ? (unsigned)(G / 8) : 0u)); }
        __syncthreads();
        const int xcc = (int)xb_xcc_id(), rank = (int)MISC[10];
        fast = __builtin_amdgcn_readfirstlane(ok ? 1 : 0) != 0;
        cid = __builtin_amdgcn_readfirstlane(fast ? 8 * rank + xcc : (int)blockIdx.x);
    }

#pragma unroll 1
    for (int l_ = 0; l_ < DEPTH; ++l_) {
#if PH & 2
        {
            PTRS();
            pg8::Gemm g{xb, (const bf16_t*)(wl + LW_IN), M, DINP, D, (size_t)16 * 256 * D * 2}; pg8::StaticOrder S; S.init(M, DINP, G, cid);
            pg8::EpiProj<0> E{(bf16_t*)(ws + WS_R1 + SL_PROJ), PLD};
            pg8::gemm_phase<pg8::EpiProj<0>, pg8::StaticOrder, true, true, pg8::RsPre>(lds, g, S, E, pg8::RsPre{ws});
        }
#endif
        GRID_SYNC();
#if PH & 4
        { PTRS();
          const int nch = M / 128;
          for (int c = fast ? (cid & 7) * (nch / 8) + (cid >> 3) : cid; c < nch; c += fast ? nch : G)
            mixer_chunk(lds, c, ws, (const bf16_t*)(wl + LW_SGU), (const float*)(ws + WS_SM_SGUB) + l * 768, (const float*)(ws + WS_SM_LNG) + l * 384, (const float*)(ws + WS_SM_LNB) + l * 384, (const float*)(ws + WS_SM_CONV) + l * 1152, (const bf16_t*)(wl + LW_POOL)); }
#endif
        GRID_SYNC();
#if PH & 8
        {
            PTRS();
            pg8::Gemm g{(const bf16_t*)(ws + WS_R1 + SL_YCAT), (const bf16_t*)(wl + LW_OUT), M, D, D, XS}; pg8::StaticOrder S; S.init(M, D, G, cid);
            pg8::EpiRes<false> E{ws};
            pg8::gemm_phase<pg8::EpiRes<false>, pg8::StaticOrder, true, true>(lds, g, S, E);
        }
#endif
        XCD_SYNC();
#if PH & 16
        {
            PTRS();
            pg8::Gemm g{xb, (const bf16_t*)(wl + LW_FF1), M, FF, D, (size_t)16 * 256 * D * 2}; pg8::StaticOrder S; S.init(M, FF, G, cid);
            pg8::EpiProj<1> E{(bf16_t*)(ws + WS_R1 + SL_HID), FF};
            pg8::gemm_phase<pg8::EpiProj<1>, pg8::StaticOrder, true, true, pg8::RsPre>(lds, g, S, E, pg8::RsPre{ws});
        }
#endif
        XCD_SYNC();
#if PH & 32
        {
            PTRS();
            pg8::Gemm g{(const bf16_t*)(ws + WS_R1 + SL_HID), (const bf16_t*)(wl + LW_FF2), M, D, FF, XS}; pg8::StaticOrder S; S.init(M, D, G, cid);
            pg8::EpiRes<false> E{ws};
            pg8::gemm_phase<pg8::EpiRes<false>, pg8::StaticOrder, true, true>(lds, g, S, E);
        }
#endif
        XCD_SYNC();
#if PH & 64
        {
            PTRS();
            pg8::Gemm g{xb, (const bf16_t*)(wl + LW_G), M, D, D, (size_t)16 * 256 * D * 2}; pg8::StaticOrder S; S.init(M, D, G, cid);
            pg8::EpiGate E{ws};
            pg8::gemm_phase<pg8::EpiGate, pg8::StaticOrder, true, true, pg8::RsPre>(lds, g, S, E, pg8::RsPre{ws});
        }
#endif
        XCD_SYNC();
#if PH & 128
        {
            PTRS();
            pg8::Gemm g{(const bf16_t*)(ws + WS_PB) + (size_t)l * M * DPLE, (const bf16_t*)(wl + LW_P), M, D, DPLE, (size_t)16 * 256 * DPLE * 2}; pg8::StaticOrder S; S.init(M, D, G, cid);
            pg8::EpiRes<true> E{ws};
            pg8::gemm_phase<pg8::EpiRes<true>, pg8::StaticOrder, true, true>(lds, g, S, E);
        }
#endif
        XCD_SYNC();
    }
#if PH & 256
    final_norm(a, fast, cid);
#endif
}

extern "C" void kernel_launch(void* const* d_in, const int* in_sizes, int n_in, void* d_out, int out_size, void* d_ws, size_t ws_size, hipStream_t stream) {
    static int grid_blocks = 0;
    if (grid_blocks == 0) {
        if (n_in != 19 || out_size != M * D || ws_size < WS_END) { fprintf(stderr, "kernel_launch: unexpected shapes (n_in %d out %d ws %zu, need %zu)\n", n_in, out_size, ws_size, (size_t)WS_END); grid_blocks = -1; return; }
        int dev = 0, cus = 0, per_cu = 0;
        hipGetDevice(&dev);
        hipDeviceGetAttribute(&cus, hipDeviceAttributeMultiprocessorCount, dev);
        if (hipFuncSetAttribute((const void*)fwd_megakernel, hipFuncAttributeMaxDynamicSharedMemorySize, LDS_BYTES) != hipSuccess) { fprintf(stderr, "kernel_launch: hipFuncSetAttribute failed\n"); grid_blocks = -1; return; }
        if (hipOccupancyMaxActiveBlocksPerMultiprocessor(&per_cu, (const void*)fwd_megakernel, 512, LDS_BYTES) != hipSuccess || per_cu < 1) { fprintf(stderr, "kernel_launch: occupancy query gave %d\n", per_cu); per_cu = 1; }
        (void)hipGetLastError();
        grid_blocks = cus * 1;
    }
    if (grid_blocks < 0) return;
    Args a{};
    for (int i = 0; i < 19; ++i) a.in[i] = (const float*)d_in[i];
    a.out = (float*)d_out; a.ws = (unsigned char*)d_ws;
    void* args[] = {&a};
    hipError_t e = hipLaunchCooperativeKernel((const void*)fwd_megakernel, dim3(grid_blocks), dim3(512), args, LDS_BYTES, stream);
    if (e != hipSuccess) fprintf(stderr, "cooperative launch failed: %s (grid %d)\n", hipGetErrorString(e), grid_blocks);
}
```
